# Optimizing an MI355X kernel written in HIP

```python
import jax, jax.numpy as jnp
from jax import lax
import numpy as np

D_MODEL = 2048
BATCH = 8
SEQ = 4096
DEPTH = 2

HEAD_DIM = 128
D_MIX = D_MODEL
CONV_WIDTH = D_MIX // 2
POOL_WIDTH = D_MIX // 4
FOURIER_WIDTH = D_MIX // 4
POOL_WINDOWS = (2, 4, 8, 16)
POOL_GROUP = POOL_WIDTH // len(POOL_WINDOWS)
FOURIER_HEADS = FOURIER_WIDTH // HEAD_DIM
IN_COLS = 3 * CONV_WIDTH + POOL_WIDTH + FOURIER_WIDTH
D_FF = ((8 * D_MODEL // 3 + 255) // 256) * 256
ALPHA = (2.0 * DEPTH) ** 0.25
BETA = (8.0 * DEPTH) ** -0.25
LN_EPS = 1e-5
RMS_EPS = 1e-6

kernel_name = "hybrid_conv_pool_fourier_deepnorm_encoder"


def layer_norm(x, g, b):
    xf = x.astype(jnp.float32)
    mu = jnp.mean(xf, axis=-1, keepdims=True)
    var = jnp.mean(jnp.square(xf - mu), axis=-1, keepdims=True)
    return ((xf - mu) * lax.rsqrt(var + LN_EPS)).astype(x.dtype) * g + b


def rms_norm(x, g):
    xf = x.astype(jnp.float32)
    ms = jnp.mean(jnp.square(xf), axis=-1, keepdims=True)
    return (xf * lax.rsqrt(ms + RMS_EPS)).astype(x.dtype) * g


def dwconv3_centred(h, w, b=None):
    hp = jnp.pad(h, ((0, 0), (1, 1), (0, 0)))
    y = hp[:, :-2] * w[0] + hp[:, 1:-1] * w[1] + hp[:, 2:] * w[2]
    return y if b is None else y + b


def multiscale_pool(h):
    bsz, s, c = h.shape
    hf = h.astype(jnp.float32)
    cs = jnp.concatenate([jnp.zeros((bsz, 1, c), jnp.float32), lax.cumsum(hf, axis=1)], axis=1)
    pos = jnp.arange(s)
    outs = []
    for gi, w in enumerate(POOL_WINDOWS):
        half = w // 2
        cg = cs[:, :, gi * POOL_GROUP:(gi + 1) * POOL_GROUP]
        hi = jnp.pad(cg[:, half:], ((0, 0), (0, half), (0, 0)), mode="edge")[:, :s]
        lo = jnp.pad(cg[:, :s - half], ((0, 0), (half, 0), (0, 0)))
        count = (jnp.minimum(pos + half, s) - jnp.maximum(pos - half, 0)).astype(jnp.float32)[None, :, None]
        outs.append((hi - lo) / count)
    pooled = jnp.concatenate(outs, axis=-1)
    return (pooled - hf).astype(h.dtype)


def fourier_mix(h):
    bsz, s, _ = h.shape
    hf = h.astype(jnp.float32).reshape(bsz, s, FOURIER_HEADS, HEAD_DIM)
    f = jnp.fft.fftn(hf, axes=(1, 3), norm="ortho").real
    return f.astype(h.dtype)


def setup_inputs(seed: int = 0) -> dict:
    key = jax.random.key(seed)
    ks = jax.random.split(key, 24)
    f32 = jnp.float32
    nrm = lambda k, shape, scale: jax.random.normal(k, shape, f32) * scale
    gain = lambda k, shape: 1.0 + 0.05 * jax.random.normal(k, shape, f32)
    bias = lambda k, shape: 0.02 * jax.random.normal(k, shape, f32)
    return {
        "x": jax.random.normal(ks[0], (BATCH, SEQ, D_MODEL), f32),
        "ln_in_g": gain(ks[1], (D_MODEL,)),
        "ln_in_b": bias(ks[2], (D_MODEL,)),
        "w_in": nrm(ks[3], (DEPTH, D_MODEL, IN_COLS), D_MODEL ** -0.5),
        "conv_a": nrm(ks[4], (DEPTH, 3, CONV_WIDTH), 3.0 ** -0.5),
        "pool_w": nrm(ks[5], (DEPTH, len(POOL_WINDOWS), POOL_GROUP, POOL_GROUP), POOL_GROUP ** -0.5),
        "pool_scale": gain(ks[6], (DEPTH, POOL_WIDTH)),
        "fourier_w": nrm(ks[7], (DEPTH, FOURIER_HEADS, HEAD_DIM, HEAD_DIM), HEAD_DIM ** -0.5),
        "mix_norm_g": gain(ks[8], (DEPTH, D_MIX)),
        "w_out": nrm(ks[9], (DEPTH, D_MIX, D_MODEL), BETA * D_MIX ** -0.5),
        "ln1_g": gain(ks[10], (DEPTH, D_MODEL)),
        "ln1_b": bias(ks[11], (DEPTH, D_MODEL)),
        "w_gate": nrm(ks[12], (DEPTH, D_MODEL, D_FF), D_MODEL ** -0.5),
        "w_up": nrm(ks[13], (DEPTH, D_MODEL, D_FF), D_MODEL ** -0.5),
        "ffn_conv_w": nrm(ks[14], (DEPTH, 3, D_FF), 3.0 ** -0.5),
        "ffn_conv_b": bias(ks[15], (DEPTH, D_FF)),
        "w_down": nrm(ks[16], (DEPTH, D_FF, D_MODEL), BETA * D_FF ** -0.5),
        "ln2_g": gain(ks[17], (DEPTH, D_MODEL)),
        "ln2_b": bias(ks[18], (DEPTH, D_MODEL)),
    }


def reference(x, ln_in_g, ln_in_b, w_in, conv_a, pool_w, pool_scale, fourier_w, mix_norm_g,
              w_out, ln1_g, ln1_b, w_gate, w_up, ffn_conv_w, ffn_conv_b, w_down, ln2_g, ln2_b):
    bsz, s, _ = x.shape
    x = layer_norm(x, ln_in_g, ln_in_b)
    c0, c1, c2 = CONV_WIDTH, 2 * CONV_WIDTH, 3 * CONV_WIDTH
    c3 = c2 + POOL_WIDTH
    for l in range(DEPTH):
        z = jnp.einsum("bsd,dc->bsc", x, w_in[l])
        gate_b, gate_c, v = z[..., :c0], z[..., c0:c1], z[..., c1:c2]
        y_a = gate_b * dwconv3_centred(gate_c * v, conv_a[l])
        pdiff = multiscale_pool(z[..., c2:c3]).reshape(bsz, s, len(POOL_WINDOWS), POOL_GROUP)
        y_b = jnp.einsum("bsgc,gcd->bsgd", pdiff, pool_w[l]).reshape(bsz, s, POOL_WIDTH) * pool_scale[l]
        fr = fourier_mix(z[..., c3:])
        y_c = jnp.einsum("bshc,hcd->bshd", fr, fourier_w[l]).reshape(bsz, s, FOURIER_WIDTH)
        g = mix_norm_g[l]
        mixed = jnp.concatenate([
            rms_norm(y_a, g[:c0]),
            rms_norm(y_b, g[c0:c0 + POOL_WIDTH]),
            rms_norm(y_c, g[c0 + POOL_WIDTH:]),
        ], axis=-1)
        mix_out = jnp.einsum("bsc,cd->bsd", mixed, w_out[l])
        x = layer_norm(ALPHA * x + mix_out, ln1_g[l], ln1_b[l])
        hg = dwconv3_centred(jnp.einsum("bsd,df->bsf", x, w_gate[l]), ffn_conv_w[l], ffn_conv_b[l])
        hu = jnp.einsum("bsd,df->bsf", x, w_up[l])
        ffn_out = jnp.einsum("bsf,fd->bsd", jax.nn.gelu(hg, approximate=False) * hu, w_down[l])
        x = layer_norm(ALPHA * x + ffn_out, ln2_g[l], ln2_b[l])
    return x
```

```cpp
#include <hip/hip_runtime.h>
#include <hip/hip_cooperative_groups.h>
#include <cstdio>
#include <cstdint>
namespace cg = cooperative_groups;

#define LAS __attribute__((address_space(3)))
typedef unsigned short bf16_t;
typedef short bf16x8 __attribute__((ext_vector_type(8)));
typedef short s16x4 __attribute__((ext_vector_type(4)));
typedef float f32x4 __attribute__((ext_vector_type(4)));
typedef float f32x2 __attribute__((ext_vector_type(2)));
typedef unsigned u32x4 __attribute__((ext_vector_type(4)));
typedef unsigned u32x2 __attribute__((ext_vector_type(2)));

constexpr int D = 2048, BATCH = 8, SEQ = 4096, DEPTH = 2, M = BATCH * SEQ;
constexpr int NZ = 4608;
constexpr int ZC_GB = 0, ZC_GC = 1024, ZC_V = 2048, ZC_POOL = 3072, ZC_FR = 3584, ZC_FI = 4096;
constexpr int DFF = 5632, NGU = 2 * DFF;
constexpr float ALPHA = 1.4142135623730951f;
constexpr float LN_EPS = 1e-5f, RMS_EPS = 1e-6f;

constexpr size_t MiB = 1u << 20;
constexpr size_t WS_WIN = 0;
constexpr size_t WS_WO = 36 * MiB;
constexpr size_t WS_WGU = 52 * MiB;
constexpr size_t WS_WD = 140 * MiB;
constexpr size_t WS_PW = 184 * MiB;
constexpr size_t WS_XB = 185 * MiB;
constexpr size_t WS_BIG = 313 * MiB;
constexpr size_t WS_Z = WS_BIG;
constexpr size_t WS_MIX = WS_BIG + 288 * MiB;
constexpr size_t WS_YP = WS_BIG + 416 * MiB;
constexpr size_t WS_END = WS_BIG + 704 * MiB;

#ifndef PHMASK
#define PHMASK 0xFFFF
#endif
#define PH(n) ((PHMASK >> (n)) & 1)
constexpr int LDS_BYTES = 155648;

__device__ __forceinline__ unsigned cvt_pk_bf16(float lo, float hi) { unsigned r; asm volatile("v_cvt_pk_bf16_f32 %0, %1, %2" : "=v"(r) : "v"(lo), "v"(hi)); return r; }
__device__ __forceinline__ bf16_t f2bf(float x) { return (bf16_t)(cvt_pk_bf16(x, 0.f) & 0xffffu); }
__device__ __forceinline__ float bf_lo(unsigned w) { return __uint_as_float(w << 16); }
__device__ __forceinline__ float bf_hi(unsigned w) { return __uint_as_float(w & 0xffff0000u); }
__device__ __forceinline__ float bf2f(bf16_t b) { return __uint_as_float(((unsigned)b) << 16); }
__device__ __forceinline__ void unpack8(const u32x4 w, float (&f)[8]) {
    f[0] = bf_lo(w.x); f[1] = bf_hi(w.x); f[2] = bf_lo(w.y); f[3] = bf_hi(w.y); f[4] = bf_lo(w.z); f[5] = bf_hi(w.z); f[6] = bf_lo(w.w); f[7] = bf_hi(w.w);
}
__device__ __forceinline__ int launder(int x) { asm volatile("" : "+v"(x)); return x; }
__device__ __forceinline__ float wave_sum(float v) {
#pragma unroll
    for (int o = 1; o < 64; o <<= 1) v += __shfl_xor(v, o);
    return v;
}

namespace pg8 {
constexpr int BM = 256, BK = 64, HALF = 128, HTB = HALF * BK * 2, STAGE_BYTES = 8 * HTB, NXCD = 8, WGM = 8;
__host__ __device__ __forceinline__ int lds_byte(int r, int c) { const int st = (r >> 4) * 2 + (c >> 5), rr = r & 15, cc = c & 31, ob = rr * 64 + cc * 2; return st * 1024 + (ob ^ (((ob >> 9) & 1) << 5)); }
__host__ __device__ __forceinline__ void stage_rc(int b, int& R, int& C) { const int st = b / 1024, sb = b % 1024, swz = sb ^ (((sb >> 9) & 1) << 5); R = (st >> 1) * 16 + swz / 64; C = (st & 1) * 32 + (swz % 64) / 2; }
__host__ __device__ __forceinline__ int perm32(int rho) { const int n = rho >> 4, i = rho & 15; return 8 * (i >> 2) + 4 * n + (i & 3); }

struct Unit { int pm, pn; };
struct Gemm { const bf16_t* A; const bf16_t* Bt; int M, N, K, lda; };

struct StaticOrder {
    int nM, nN, nwg, G, c;
    __device__ void init(int M_, int N_, int G_, int c_) { nM = M_ / BM; nN = N_ / BM; nwg = nM * nN; G = G_; c = c_; }
    __device__ bool next(int i, Unit& u) const {
        const long L = (long)i * G + c; if (L >= nwg) return false;
        int wgid = (int)L; { const int q = nwg / NXCD, r = nwg % NXCD, xcd = wgid % NXCD, off = wgid / NXCD; wgid = (xcd < r ? xcd * (q + 1) : r * (q + 1) + (xcd - r) * q) + off; }
        const int nig = WGM * nN, gid = wgid / nig, fm = gid * WGM, gsz = (nM - fm) < WGM ? (nM - fm) : WGM;
        u.pm = fm + ((wgid % nig) % gsz); u.pn = (wgid % nig) / gsz; return true;
    }
};

struct EpiBf16 {
    static constexpr bool PERM = true;
    bf16_t* O; int ldc;
    __device__ __forceinline__ void operator()(const f32x4 (&acc)[2][2][4][2], const Unit& u, int wr, int wc, int fr, int fq) const {
        const int row0 = u.pm * BM + wr * 64 + fr; const int col0 = u.pn * BM + wc * 32 + 8 * fq;
#pragma unroll
        for (int ai = 0; ai < 2; ++ai)
#pragma unroll
            for (int m = 0; m < 4; ++m) { bf16_t* rowp = O + (size_t)(row0 + ai * HALF + m * 16) * ldc + col0;
#pragma unroll
                for (int bj = 0; bj < 2; ++bj) { const f32x4 v0 = acc[ai][bj][m][0], v1 = acc[ai][bj][m][1];
                    u32x4 w; w.x = cvt_pk_bf16(v0[0], v0[1]); w.y = cvt_pk_bf16(v0[2], v0[3]); w.z = cvt_pk_bf16(v1[0], v1[1]); w.w = cvt_pk_bf16(v1[2], v1[3]);
                    *(u32x4*)(rowp + bj * HALF) = w; } }
    }
};
struct EpiRes {
    static constexpr bool PERM = false;
    float* X; int ldc; float alpha;
    __device__ __forceinline__ void operator()(const f32x4 (&acc)[2][2][4][2], const Unit& u, int wr, int wc, int fr, int fq) const {
        const int row0 = u.pm * BM + wr * 64 + fr, col0 = u.pn * BM + wc * 32 + 4 * fq;
#pragma unroll
        for (int ai = 0; ai < 2; ++ai)
#pragma unroll
            for (int m = 0; m < 4; ++m) { float* rowp = X + (size_t)(row0 + ai * HALF + m * 16) * ldc + col0;
#pragma unroll
                for (int bj = 0; bj < 2; ++bj)
#pragma unroll
                    for (int n = 0; n < 2; ++n) { f32x4* p = (f32x4*)(rowp + bj * HALF + n * 16); const f32x4 xv = *p; *p = xv * alpha + acc[ai][bj][m][n]; }
                asm volatile("" ::: "memory"); }
    }
};

template <class Epi, bool ALIGN_EPI>
__device__ __forceinline__ void gemm_phase(LAS unsigned char* lds, const Gemm g, const StaticOrder& S, const Epi& E) {
    const int tid = launder(threadIdx.x), wid = __builtin_amdgcn_readfirstlane(tid >> 6), lane = tid & 63, wr = wid >> 2, wc = wid & 3, fr = lane & 15, fq = lane >> 4;
    const int K = g.K, nt = K / BK, lda = g.lda;
    unsigned voffA[2], voffB[2];
#pragma unroll
    for (int i = 0; i < 2; ++i) { int R, C; stage_rc(tid * 16 + i * 8192, R, C); const int Rb = Epi::PERM ? ((R & ~31) + perm32(R & 31)) : R;
        voffA[i] = (unsigned)(R * lda + C) * 2u; voffB[i] = (unsigned)(Rb * K + C) * 2u; }
    const size_t kstep = (size_t)(BK * 2);
    const size_t hstepA = (size_t)HALF * lda * 2, hstepB = (size_t)HALF * K * 2;
    const size_t tstepA = 2 * hstepA, tstepB = 2 * hstepB;
    const unsigned ldsw = (unsigned)wid * 1024u;
    const int aoff = lds_byte(wr * 64 + fr, fq * 8), boff = lds_byte(wc * 32 + fr, fq * 8);
#define PG8_SA(b, h) (((b) * 2 + (h)) * HTB)
#define PG8_SB(b, h) ((4 + (b) * 2 + (h)) * HTB)
#define PG8_STAGE(bufoff, gbase, voff) do { _Pragma("unroll") for (int _i = 0; _i < 2; ++_i) \
        __builtin_amdgcn_global_load_lds((const unsigned*)((const char*)(gbase) + (voff)[_i]), (LAS unsigned*)(lds + (bufoff) + ldsw + _i * 8192), 16, 0, 0); } while (0)
#define PG8_LDA(dst, b, h) do { _Pragma("unroll") for (int m = 0; m < 4; ++m) _Pragma("unroll") for (int k = 0; k < 2; ++k) dst[m][k] = *(const LAS bf16x8*)(lds + PG8_SA(b, h) + aoff + m * 2048 + k * 1024); } while (0)
#define PG8_LDB(dst, b, h) do { _Pragma("unroll") for (int n = 0; n < 2; ++n) _Pragma("unroll") for (int k = 0; k < 2; ++k) dst[n][k] = *(const LAS bf16x8*)(lds + PG8_SB(b, h) + boff + n * 2048 + k * 1024); } while (0)
#define PG8_MMA(ai, bj, At, Bt) do { __builtin_amdgcn_s_setprio(1); _Pragma("unroll") for (int m = 0; m < 4; ++m) _Pragma("unroll") for (int n = 0; n < 2; ++n) _Pragma("unroll") for (int k = 0; k < 2; ++k) \
        acc[ai][bj][m][n] = __builtin_amdgcn_mfma_f32_16x16x32_bf16(Bt[n][k], At[m][k], acc[ai][bj][m][n], 0, 0, 0); __builtin_amdgcn_s_setprio(0); } while (0)
#define PG8_WAIT_V(n) asm volatile("s_waitcnt vmcnt(" #n ")" ::: "memory")
#define PG8_WAIT_L(n) asm volatile("s_waitcnt lgkmcnt(" #n ")" ::: "memory")
#define PG8_BAR __builtin_amdgcn_s_barrier()
#define PG8_SCHED __builtin_amdgcn_sched_barrier(0)
    Unit cur, nxt; int ui = 0;
    if (!S.next(0, cur)) return;
    f32x4 acc[2][2][4][2];
#pragma unroll
    for (int a = 0; a < 2; ++a)
#pragma unroll
        for (int b = 0; b < 2; ++b)
#pragma unroll
            for (int m = 0; m < 4; ++m)
#pragma unroll
                for (int n = 0; n < 2; ++n) acc[a][b][m][n] = (f32x4){0.f, 0.f, 0.f, 0.f};
    bf16x8 At[4][2], B0[2][2], B1[2][2];
    const char* cA = (const char*)g.A + (size_t)cur.pm * tstepA; const char* cB = (const char*)g.Bt + (size_t)cur.pn * tstepB;
    PG8_STAGE(PG8_SB(0, 0), cB, voffB); PG8_STAGE(PG8_SB(0, 1), cB + hstepB, voffB); PG8_STAGE(PG8_SA(0, 0), cA, voffA); PG8_STAGE(PG8_SA(0, 1), cA + hstepA, voffA);
    if (wr == 1) PG8_BAR;
    PG8_WAIT_V(2); PG8_BAR;
    PG8_STAGE(PG8_SB(1, 0), cB + kstep, voffB); PG8_STAGE(PG8_SA(1, 0), cA + kstep, voffA); PG8_STAGE(PG8_SB(1, 1), cB + hstepB + kstep, voffB);
    PG8_WAIT_V(6); PG8_BAR;
    for (;;) {
        const bool has_next = S.next(ui + 1, nxt);
        const char* nA = has_next ? (const char*)g.A + (size_t)nxt.pm * tstepA : cA; const char* nB = has_next ? (const char*)g.Bt + (size_t)nxt.pn * tstepB : cB;
        for (int t = 0; t < nt; t += 2) {
            const bool last = (t == nt - 2);
            const char* a1 = cA + (size_t)(t + 1) * kstep;
            const char* a2 = last ? nA : cA + (size_t)(t + 2) * kstep; const char* b2 = last ? nB : cB + (size_t)(t + 2) * kstep;
            const char* a3 = a2 + kstep; const char* b3 = b2 + kstep;
            PG8_LDB(B0, 0, 0); PG8_LDB(B1, 0, 1); PG8_SCHED; PG8_LDA(At, 0, 0); PG8_STAGE(PG8_SA(1, 1), a1 + hstepA, voffA);
            PG8_WAIT_V(8); PG8_WAIT_L(0); PG8_BAR; PG8_MMA(0, 0, At, B0); PG8_MMA(0, 1, At, B1); PG8_BAR; PG8_SCHED;
            PG8_LDA(At, 0, 1); PG8_STAGE(PG8_SB(0, 0), b2, voffB); PG8_STAGE(PG8_SB(0, 1), b2 + hstepB, voffB); PG8_STAGE(PG8_SA(0, 0), a2, voffA);
            PG8_WAIT_V(8); PG8_WAIT_L(0); PG8_BAR; PG8_MMA(1, 0, At, B0); PG8_MMA(1, 1, At, B1); PG8_BAR; PG8_SCHED;
            PG8_LDB(B0, 1, 0); PG8_LDB(B1, 1, 1); PG8_SCHED; PG8_LDA(At, 1, 0); PG8_STAGE(PG8_SA(0, 1), a2 + hstepA, voffA);
            PG8_WAIT_V(8); PG8_WAIT_L(0); PG8_BAR; PG8_MMA(0, 0, At, B0); PG8_MMA(0, 1, At, B1); PG8_BAR; PG8_SCHED;
            PG8_LDA(At, 1, 1); PG8_STAGE(PG8_SB(1, 0), b3, voffB); PG8_STAGE(PG8_SB(1, 1), b3 + hstepB, voffB); PG8_STAGE(PG8_SA(1, 0), a3, voffA);
            PG8_WAIT_V(8); PG8_WAIT_L(0); PG8_BAR; PG8_MMA(1, 0, At, B0); PG8_MMA(1, 1, At, B1); PG8_BAR; PG8_SCHED;
        }
        if constexpr (ALIGN_EPI) { if (wr == 0) PG8_BAR; }
        E(acc, cur, wr, wc, fr, fq);
        if (!has_next) break;
#pragma unroll
        for (int a = 0; a < 2; ++a)
#pragma unroll
            for (int b = 0; b < 2; ++b)
#pragma unroll
                for (int m = 0; m < 4; ++m)
#pragma unroll
                    for (int n = 0; n < 2; ++n) acc[a][b][m][n] = (f32x4){0.f, 0.f, 0.f, 0.f};
        cur = nxt; cA = nA; cB = nB; ++ui;
        if constexpr (ALIGN_EPI) { if (wr == 1) PG8_BAR; }
    }
    PG8_WAIT_V(0);
    if constexpr (!ALIGN_EPI) { if (wr == 0) PG8_BAR; }
    PG8_BAR;
#undef PG8_SA
#undef PG8_SB
#undef PG8_STAGE
#undef PG8_LDA
#undef PG8_LDB
#undef PG8_MMA
#undef PG8_WAIT_V
#undef PG8_WAIT_L
#undef PG8_BAR
#undef PG8_SCHED
}
}

struct Args { const float* in[19]; float* out; unsigned char* ws; };

#define LDS_WAIT() asm volatile("s_waitcnt lgkmcnt(0)" ::: "memory")

__device__ __forceinline__ void p0_transpose_item(const float* W, int K, int pitch, int nblk, bf16_t* WT, int row_off, LAS float* scr, int item, int lane) {
    const int kb = item / nblk, nb = item % nblk, k0 = 64 * kb, n0 = 32 * nb;
#pragma unroll 8
    for (int i = 0; i < 32; ++i) { const int kk = 2 * i + (lane >> 5); scr[kk * 33 + (lane & 31)] = W[(size_t)(k0 + kk) * pitch + n0 + (lane & 31)]; }
    LDS_WAIT(); asm volatile("" ::: "memory");
    const int c = lane & 7;
#pragma unroll
    for (int j = 0; j < 4; ++j) { const int n = (lane >> 3) + 8 * j; const LAS float* s = scr + (8 * c) * 33 + n;
        u32x4 o; o.x = cvt_pk_bf16(s[0 * 33], s[1 * 33]); o.y = cvt_pk_bf16(s[2 * 33], s[3 * 33]); o.z = cvt_pk_bf16(s[4 * 33], s[5 * 33]); o.w = cvt_pk_bf16(s[6 * 33], s[7 * 33]);
        *(u32x4*)(WT + (size_t)(row_off + n0 + n) * K + k0 + 8 * c) = o; }
    LDS_WAIT(); asm volatile("" ::: "memory");
}

__device__ __forceinline__ void ln_row(const float* xrow, const float* g, const float* b, float* orow, bf16_t* obrow, int lane) {
    const f32x4* xr = (const f32x4*)xrow + lane;
    f32x4 v[8]; float s = 0.f;
#pragma unroll
    for (int j = 0; j < 8; ++j) { v[j] = xr[64 * j]; s += (v[j].x + v[j].y) + (v[j].z + v[j].w); }
    const float mean = wave_sum(s) * (1.f / D); float s2 = 0.f;
#pragma unroll
    for (int j = 0; j < 8; ++j) { v[j] = v[j] - mean; s2 += (v[j].x * v[j].x + v[j].y * v[j].y) + (v[j].z * v[j].z + v[j].w * v[j].w); }
    const float rstd = 1.f / sqrtf(wave_sum(s2) * (1.f / D) + LN_EPS);
    const f32x4* gp = (const f32x4*)g + lane; const f32x4* bp = (const f32x4*)b + lane;
    f32x4* op = (f32x4*)orow + lane; u32x2* ob = (u32x2*)obrow + lane;
#pragma unroll
    for (int j = 0; j < 8; ++j) { const f32x4 o = v[j] * rstd * gp[64 * j] + bp[64 * j]; op[64 * j] = o;
        u32x2 w; w.x = cvt_pk_bf16(o.x, o.y); w.y = cvt_pk_bf16(o.z, o.w); ob[64 * j] = w; }
}

__global__ void __launch_bounds__(512, 2) fwd_kernel(Args args) {
    extern __shared__ __attribute__((aligned(16))) unsigned char lds_raw[];
    LAS unsigned char* lds = (LAS unsigned char*)lds_raw;
    cg::grid_group grid = cg::this_grid();
    const int tid0 = threadIdx.x, wave = __builtin_amdgcn_readfirstlane(tid0 >> 6);
    const int G = gridDim.x, bid = blockIdx.x;
    const int gw = bid * 8 + wave, NGW = G * 8;
    unsigned char* ws = args.ws;
    float* X = args.out;
    bf16_t* XB = (bf16_t*)(ws + WS_XB);
    bf16_t* Z = (bf16_t*)(ws + WS_Z);
    bf16_t* MIX = (bf16_t*)(ws + WS_MIX);
    bf16_t* YP = (bf16_t*)(ws + WS_YP);
    bf16_t* GU = (bf16_t*)(ws + WS_BIG);
    bf16_t* PWT = (bf16_t*)(ws + WS_PW);

    if (PH(0)) {
        const int tid = launder(tid0), lane = tid & 63;
        for (int it = bid; it < 256; it += G) {
            const int l = it >> 7, h = (it >> 5) & 3, cs = (it >> 4) & 1, kc = it & 15;
            LAS float* CW = (LAS float*)lds;
            {
                const int c = tid >> 2, d0 = (tid & 3) * 32;
                float a[32];
#pragma unroll
                for (int j = 0; j < 32; ++j) a[j] = 0.f;
                const float* Wf = args.in[7] + ((size_t)(l * 4 + h) * 128) * 128 + d0;
                for (int cp = 0; cp < 128; ++cp) {
                    const float fr_ = (float)((c * cp) & 127) * (1.f / 128.f);
                    const float tw = cs ? -__builtin_amdgcn_sinf(fr_) : __builtin_amdgcn_cosf(fr_);
                    const f32x4* wr_ = (const f32x4*)(Wf + (size_t)cp * 128);
#pragma unroll
                    for (int j = 0; j < 8; ++j) { const f32x4 w = wr_[j]; a[4 * j] += tw * w.x; a[4 * j + 1] += tw * w.y; a[4 * j + 2] += tw * w.z; a[4 * j + 3] += tw * w.w; }
                }
#pragma unroll
                for (int j = 0; j < 32; ++j) CW[c * 128 + d0 + j] = a[j] * 0.08838834764831845f;
            }
            __syncthreads();
            {
                const int k = kc * 128 + (tid & 127), d0 = (tid >> 7) * 32;
                float a[32];
#pragma unroll
                for (int j = 0; j < 32; ++j) a[j] = 0.f;
                const float* wrow = args.in[3] + ((size_t)l * D + k) * 4096 + 3584 + h * 128;
                for (int c4 = 0; c4 < 32; ++c4) {
                    const f32x4 wv = *(const f32x4*)(wrow + 4 * c4);
#pragma unroll
                    for (int cc = 0; cc < 4; ++cc) { const float av = wv[cc]; const LAS f32x4* cwp = (const LAS f32x4*)(CW + (4 * c4 + cc) * 128 + d0);
#pragma unroll
                        for (int j = 0; j < 8; ++j) { const f32x4 w = cwp[j]; a[4 * j] += av * w.x; a[4 * j + 1] += av * w.y; a[4 * j + 2] += av * w.z; a[4 * j + 3] += av * w.w; } }
                }
                bf16_t* dst = (bf16_t*)(ws + WS_WIN) + ((size_t)l * NZ + ZC_FR + cs * 512 + h * 128 + d0) * D + k;
#pragma unroll
                for (int j = 0; j < 32; ++j) dst[(size_t)j * D] = f2bf(a[j]);
            }
            __syncthreads();
        }
        {
            LAS float* scr = (LAS float*)(lds + wave * 16384);
            constexpr int I_IN = 32 * 112, I_O = 32 * 64, I_G = 32 * 176, I_D = 88 * 64, I_L = I_IN + I_O + 2 * I_G + I_D;
            for (int it = gw; it < 2 * I_L; it += NGW) {
                const int l = it / I_L; int r = it - l * I_L;
                if (r < I_IN) { p0_transpose_item(args.in[3] + (size_t)l * D * 4096, D, 4096, 112, (bf16_t*)(ws + WS_WIN) + (size_t)l * NZ * D, 0, scr, r, lane); continue; } r -= I_IN;
                if (r < I_O) { p0_transpose_item(args.in[9] + (size_t)l * D * D, D, D, 64, (bf16_t*)(ws + WS_WO) + (size_t)l * D * D, 0, scr, r, lane); continue; } r -= I_O;
                if (r < I_G) { p0_transpose_item(args.in[12] + (size_t)l * D * DFF, D, DFF, 176, (bf16_t*)(ws + WS_WGU) + (size_t)l * NGU * D, 0, scr, r, lane); continue; } r -= I_G;
                if (r < I_G) { p0_transpose_item(args.in[13] + (size_t)l * D * DFF, D, DFF, 176, (bf16_t*)(ws + WS_WGU) + (size_t)l * NGU * D, DFF, scr, r, lane); continue; } r -= I_G;
                p0_transpose_item(args.in[16] + (size_t)l * DFF * D, DFF, D, 64, (bf16_t*)(ws + WS_WD) + (size_t)l * D * DFF, 0, scr, r, lane);
            }
        }
        for (int i = bid * 512 + tid; i < 2 * 4 * 128 * 128; i += G * 512) { const int c = i & 127, d = (i >> 7) & 127, lg = i >> 14; PWT[i] = f2bf(args.in[5][((size_t)lg * 128 + c) * 128 + d]); }
        for (int m = gw; m < M; m += NGW) ln_row(args.in[0] + (size_t)m * D, args.in[1], args.in[2], X + (size_t)m * D, XB + (size_t)m * D, lane);
    }
    grid.sync();

    for (int l = 0; l < DEPTH; ++l) {
        if (PH(1)) {
            pg8::Gemm g{XB, (const bf16_t*)(ws + WS_WIN) + (size_t)l * NZ * D, M, NZ, D, D}; pg8::StaticOrder S; S.init(M, NZ, G, bid);
            pg8::EpiBf16 E{Z, NZ};
            pg8::gemm_phase<pg8::EpiBf16, true>(lds, g, S, E);
        }
        grid.sync();
        if (PH(2)) {
            const int tid = launder(tid0), lane = tid & 63;
            const float* gmix = args.in[8] + (size_t)l * D;
            LAS unsigned char* M1p = lds;
            LAS unsigned char* tile = lds + 128 * 272;
            for (int i = tid; i < 128 * 128; i += 512) {
                const int o = i >> 7, ks_ = (i >> 5) & 3, kq = (i >> 3) & 3, e = (i >> 2) & 1, q = i & 3;
                const int ro = o >> 6, k1 = o & 63, ri = ks_ >> 1, t1 = (ks_ & 1) * 32 + 16 * e + 4 * kq + q;
                const float fr_ = (float)((k1 * t1) & 63) * (1.f / 64.f);
                const float c = __builtin_amdgcn_cosf(fr_) * 0.125f, s = __builtin_amdgcn_sinf(fr_) * 0.125f;
                const float v = (ro == ri) ? c : (ro == 0 ? s : -s);
                *(LAS bf16_t*)(M1p + o * 272 + (i & 127) * 2) = f2bf(v);
            }
            __syncthreads();
            const int fr = lane & 15, fq = lane >> 4, qq = fr >> 2, pp = fr & 3;
            for (int it = bid; it < 1024; it += G) {
                const int b = it >> 7, t2 = (it >> 1) & 63, half = it & 1;
#pragma unroll
                for (int i = 0; i < 8; ++i) { const int idx = tid + 512 * i, row = idx >> 6, ch = idx & 63, ri = ch >> 5, cc = ch & 31;
                    const u32x4 v = *(const u32x4*)(Z + (size_t)(b * SEQ + 64 * row + t2) * NZ + ZC_FR + ri * 512 + half * 256 + cc * 8);
                    *(LAS u32x4*)(tile + row * 1056 + ri * 512 + cc * 16) = v; }
                __syncthreads();
                f32x4 acc[8][2];
#pragma unroll
                for (int a = 0; a < 8; ++a) { acc[a][0] = (f32x4){0.f, 0.f, 0.f, 0.f}; acc[a][1] = (f32x4){0.f, 0.f, 0.f, 0.f}; }
#pragma unroll
                for (int ks_ = 0; ks_ < 4; ++ks_) {
                    const int ri = ks_ >> 1, T0 = (ks_ & 1) * 32;
                    bf16x8 bfrag[2];
#pragma unroll
                    for (int nb = 0; nb < 2; ++nb) {
                        const int cb = (ri * 256 + 32 * wave + nb * 16 + 4 * pp) * 2;
                        const s16x4 lo = __builtin_amdgcn_ds_read_tr16_b64_v4i16((LAS s16x4*)(tile + (T0 + 4 * fq + qq) * 1056 + cb));
                        const s16x4 hi = __builtin_amdgcn_ds_read_tr16_b64_v4i16((LAS s16x4*)(tile + (T0 + 16 + 4 * fq + qq) * 1056 + cb));
                        bfrag[nb] = (bf16x8){lo.x, lo.y, lo.z, lo.w, hi.x, hi.y, hi.z, hi.w};
                    }
#pragma unroll
                    for (int ob = 0; ob < 8; ++ob) {
                        const bf16x8 af = *(const LAS bf16x8*)(M1p + (ob * 16 + fr) * 272 + (ks_ * 32 + fq * 8) * 2);
                        acc[ob][0] = __builtin_amdgcn_mfma_f32_16x16x32_bf16(af, bfrag[0], acc[ob][0], 0, 0, 0);
                        acc[ob][1] = __builtin_amdgcn_mfma_f32_16x16x32_bf16(af, bfrag[1], acc[ob][1], 0, 0, 0);
                    }
                }
#pragma unroll
                for (int ob = 0; ob < 4; ++ob)
#pragma unroll
                    for (int e = 0; e < 4; ++e) {
                        const int k1 = ob * 16 + 4 * fq + e;
                        const float fr_ = (float)(k1 * t2) * (1.f / 4096.f);
                        const float ct = __builtin_amdgcn_cosf(fr_), st = __builtin_amdgcn_sinf(fr_);
                        bf16_t* dst = YP + ((size_t)((b * 64 + k1) * 64 + t2)) * 1024 + half * 256 + 32 * wave + fr;
#pragma unroll
                        for (int nb = 0; nb < 2; ++nb) {
                            const float yr = acc[ob][nb][e], yi = acc[ob + 4][nb][e];
                            dst[nb * 16] = f2bf(yr * ct + yi * st);
                            dst[512 + nb * 16] = f2bf(yi * ct - yr * st);
                        }
                    }
                __syncthreads();
            }
            {
                LAS unsigned char* Ht = lds;
                LAS unsigned char* Pt = lds + 48 * 1040;
                LAS float* red = (LAS float*)(lds + 48 * 1040 + 32 * 1040);
                const bf16_t* pw = PWT + (size_t)l * 4 * 128 * 128;
                const float* pscale = args.in[6] + (size_t)l * 512;
                const int g_ = wave >> 1, dh = wave & 1;
                for (int it = bid; it < M / 32; it += G) {
                    const int r0 = it * 32, t0 = r0 & (SEQ - 1);
#pragma unroll
                    for (int i = 0; i < 6; ++i) { const int idx = tid + 512 * i, row = idx >> 6, ch = idx & 63; const int t = t0 - 8 + row;
                        u32x4 v = (u32x4){0u, 0u, 0u, 0u};
                        if (t >= 0 && t < SEQ) v = *(const u32x4*)(Z + (size_t)(r0 - 8 + row) * NZ + ZC_POOL + ch * 8);
                        *(LAS u32x4*)(Ht + row * 1040 + ch * 16) = v; }
                    __syncthreads();
                    {
                        const int c = tid, gi = c >> 7, hf = 1 << gi;
                        float s = 0.f;
                        for (int j = -hf; j < hf; ++j) s += bf2f(*(const LAS bf16_t*)(Ht + (8 + j) * 1040 + c * 2));
                        for (int tt = 0; tt < 32; ++tt) {
                            const int t = t0 + tt;
                            const int hi_ = (t + hf < SEQ) ? t + hf : SEQ, lo_ = (t - hf > 0) ? t - hf : 0;
                            const float cnt = (float)(hi_ - lo_);
                            const float hc = bf2f(*(const LAS bf16_t*)(Ht + (8 + tt) * 1040 + c * 2));
                            *(LAS bf16_t*)(Pt + tt * 1040 + c * 2) = f2bf(s / cnt - hc);
                            s += bf2f(*(const LAS bf16_t*)(Ht + (8 + tt + hf) * 1040 + c * 2)) - bf2f(*(const LAS bf16_t*)(Ht + (8 + tt - hf) * 1040 + c * 2));
                        }
                    }
                    __syncthreads();
                    f32x4 acc[2][4];
#pragma unroll
                    for (int a = 0; a < 2; ++a)
#pragma unroll
                        for (int n = 0; n < 4; ++n) acc[a][n] = (f32x4){0.f, 0.f, 0.f, 0.f};
#pragma unroll
                    for (int ks_ = 0; ks_ < 4; ++ks_) {
                        bf16x8 tf[2];
#pragma unroll
                        for (int mb = 0; mb < 2; ++mb) tf[mb] = *(const LAS bf16x8*)(Pt + (mb * 16 + fr) * 1040 + (g_ * 128 + ks_ * 32 + fq * 8) * 2);
#pragma unroll
                        for (int nb = 0; nb < 4; ++nb) {
                            const bf16x8 wf = *(const bf16x8*)(pw + ((size_t)(g_ * 128 + dh * 64 + nb * 16 + fr)) * 128 + ks_ * 32 + fq * 8);
                            acc[0][nb] = __builtin_amdgcn_mfma_f32_16x16x32_bf16(wf, tf[0], acc[0][nb], 0, 0, 0);
                            acc[1][nb] = __builtin_amdgcn_mfma_f32_16x16x32_bf16(wf, tf[1], acc[1][nb], 0, 0, 0);
                        }
                    }
                    float ssq[2] = {0.f, 0.f};
#pragma unroll
                    for (int nb = 0; nb < 4; ++nb) { const f32x4 sc = *(const f32x4*)(pscale + g_ * 128 + dh * 64 + nb * 16 + 4 * fq);
#pragma unroll
                        for (int mb = 0; mb < 2; ++mb) { acc[mb][nb] = acc[mb][nb] * sc; const f32x4 v = acc[mb][nb]; ssq[mb] += (v.x * v.x + v.y * v.y) + (v.z * v.z + v.w * v.w); } }
#pragma unroll
                    for (int mb = 0; mb < 2; ++mb) { ssq[mb] += __shfl_xor(ssq[mb], 16); ssq[mb] += __shfl_xor(ssq[mb], 32); if (fq == 0) red[(mb * 16 + fr) * 8 + wave] = ssq[mb]; }
                    __syncthreads();
#pragma unroll
                    for (int mb = 0; mb < 2; ++mb) {
                        const LAS f32x4* rp = (const LAS f32x4*)(red + (mb * 16 + fr) * 8); const f32x4 ra = rp[0], rb = rp[1];
                        const float tot = ((ra.x + ra.y) + (ra.z + ra.w)) + ((rb.x + rb.y) + (rb.z + rb.w));
                        const float rstd = 1.f / sqrtf(tot * (1.f / 512.f) + RMS_EPS);
                        bf16_t* orow = MIX + (size_t)(r0 + mb * 16 + fr) * D + 1024 + g_ * 128 + dh * 64 + 4 * fq;
#pragma unroll
                        for (int nb = 0; nb < 4; ++nb) { const f32x4 gm = *(const f32x4*)(gmix + 1024 + g_ * 128 + dh * 64 + nb * 16 + 4 * fq); const f32x4 o = acc[mb][nb] * rstd * gm;
                            u32x2 w; w.x = cvt_pk_bf16(o.x, o.y); w.y = cvt_pk_bf16(o.z, o.w); *(u32x2*)(orow + nb * 16) = w; }
                    }
                    __syncthreads();
                }
            }
            {
                const float* ca = args.in[4] + (size_t)l * 3 * 1024;
                float a0[16], a1[16], a2[16], gm[16];
#pragma unroll
                for (int h = 0; h < 2; ++h)
#pragma unroll
                    for (int j = 0; j < 8; ++j) { const int c = h * 512 + lane * 8 + j; a0[h * 8 + j] = ca[c]; a1[h * 8 + j] = ca[1024 + c]; a2[h * 8 + j] = ca[2048 + c]; gm[h * 8 + j] = gmix[c]; }
                for (int run = gw; run < M / 16; run += NGW) {
                    const int r0 = run * 16, t0 = r0 & (SEQ - 1);
                    float up[16], uc[16], un[16];
#define LOAD_U(dst, r) do { _Pragma("unroll") for (int h = 0; h < 2; ++h) { const bf16_t* zp = Z + (size_t)(r) * NZ + h * 512 + lane * 8; \
                        float c_[8], v_[8]; unpack8(*(const u32x4*)(zp + ZC_GC), c_); unpack8(*(const u32x4*)(zp + ZC_V), v_); \
                        _Pragma("unroll") for (int j = 0; j < 8; ++j) dst[h * 8 + j] = c_[j] * v_[j]; } } while (0)
                    if (t0 > 0) { LOAD_U(up, r0 - 1); } else {
#pragma unroll
                        for (int j = 0; j < 16; ++j) up[j] = 0.f; }
                    LOAD_U(uc, r0);
                    for (int i = 0; i < 16; ++i) {
                        const int r = r0 + i;
                        if (t0 + i < SEQ - 1) { LOAD_U(un, r + 1); } else {
#pragma unroll
                            for (int j = 0; j < 16; ++j) un[j] = 0.f; }
                        float y[16]; float ss = 0.f;
#pragma unroll
                        for (int h = 0; h < 2; ++h) { float gb[8]; unpack8(*(const u32x4*)(Z + (size_t)r * NZ + ZC_GB + h * 512 + lane * 8), gb);
#pragma unroll
                            for (int j = 0; j < 8; ++j) { const int k = h * 8 + j; y[k] = gb[j] * (a0[k] * up[k] + a1[k] * uc[k] + a2[k] * un[k]); ss += y[k] * y[k]; } }
                        const float rstd = 1.f / sqrtf(wave_sum(ss) * (1.f / 1024.f) + RMS_EPS);
#pragma unroll
                        for (int h = 0; h < 2; ++h) { u32x4 w;
                            w.x = cvt_pk_bf16(y[h * 8 + 0] * rstd * gm[h * 8 + 0], y[h * 8 + 1] * rstd * gm[h * 8 + 1]); w.y = cvt_pk_bf16(y[h * 8 + 2] * rstd * gm[h * 8 + 2], y[h * 8 + 3] * rstd * gm[h * 8 + 3]);
                            w.z = cvt_pk_bf16(y[h * 8 + 4] * rstd * gm[h * 8 + 4], y[h * 8 + 5] * rstd * gm[h * 8 + 5]); w.w = cvt_pk_bf16(y[h * 8 + 6] * rstd * gm[h * 8 + 6], y[h * 8 + 7] * rstd * gm[h * 8 + 7]);
                            *(u32x4*)(MIX + (size_t)r * D + h * 512 + lane * 8) = w; }
#pragma unroll
                        for (int j = 0; j < 16; ++j) { up[j] = uc[j]; uc[j] = un[j]; }
                    }
#undef LOAD_U
                }
            }
        }
        grid.sync();
        if (PH(3)) {
            const int tid = launder(tid0), lane = tid & 63;
            const float* gmix = args.in[8] + (size_t)l * D;
            LAS unsigned char* M2p = lds;
            LAS unsigned char* tile = lds + 64 * 272;
            LAS float* red = (LAS float*)(lds + 64 * 272 + 64 * 2080);
            for (int i = tid; i < 64 * 128; i += 512) {
                const int o = i >> 7, ks_ = (i >> 5) & 3, kq = (i >> 3) & 3, e = (i >> 2) & 1, q = i & 3;
                const int ri = ks_ >> 1, t2 = (ks_ & 1) * 32 + 16 * e + 4 * kq + q;
                const float fr_ = (float)((o * t2) & 63) * (1.f / 64.f);
                const float v = (ri == 0 ? __builtin_amdgcn_cosf(fr_) : __builtin_amdgcn_sinf(fr_)) * 0.125f;
                *(LAS bf16_t*)(M2p + o * 272 + (i & 127) * 2) = f2bf(v);
            }
            __syncthreads();
            const int fr = lane & 15, fq = lane >> 4, qq = fr >> 2, pp = fr & 3;
            for (int it = bid; it < 512; it += G) {
                const int b = it >> 6, k1 = it & 63;
                const bf16_t* src = YP + (size_t)((b * 64 + k1) * 64) * 1024;
#pragma unroll
                for (int i = 0; i < 16; ++i) { const int idx = tid + 512 * i, row = idx >> 7, ch = idx & 127;
                    *(LAS u32x4*)(tile + row * 2080 + ch * 16) = *(const u32x4*)(src + (size_t)row * 1024 + ch * 8); }
                __syncthreads();
                f32x4 acc[4][4];
#pragma unroll
                for (int a = 0; a < 4; ++a)
#pragma unroll
                    for (int n = 0; n < 4; ++n) acc[a][n] = (f32x4){0.f, 0.f, 0.f, 0.f};
#pragma unroll
                for (int ks_ = 0; ks_ < 4; ++ks_) {
                    const int ri = ks_ >> 1, T0 = (ks_ & 1) * 32;
                    bf16x8 af[4];
#pragma unroll
                    for (int ob = 0; ob < 4; ++ob) af[ob] = *(const LAS bf16x8*)(M2p + (ob * 16 + fr) * 272 + (ks_ * 32 + fq * 8) * 2);
#pragma unroll
                    for (int nb = 0; nb < 4; ++nb) {
                        const int cb = (ri * 512 + 64 * wave + nb * 16 + 4 * pp) * 2;
                        const s16x4 lo = __builtin_amdgcn_ds_read_tr16_b64_v4i16((LAS s16x4*)(tile + (T0 + 4 * fq + qq) * 2080 + cb));
                        const s16x4 hi = __builtin_amdgcn_ds_read_tr16_b64_v4i16((LAS s16x4*)(tile + (T0 + 16 + 4 * fq + qq) * 2080 + cb));
                        const bf16x8 bf = (bf16x8){lo.x, lo.y, lo.z, lo.w, hi.x, hi.y, hi.z, hi.w};
#pragma unroll
                        for (int ob = 0; ob < 4; ++ob) acc[ob][nb] = __builtin_amdgcn_mfma_f32_16x16x32_bf16(af[ob], bf, acc[ob][nb], 0, 0, 0);
                    }
                }
#pragma unroll
                for (int ob = 0; ob < 4; ++ob)
#pragma unroll
                    for (int e = 0; e < 4; ++e) {
                        float s = 0.f;
#pragma unroll
                        for (int nb = 0; nb < 4; ++nb) s += acc[ob][nb][e] * acc[ob][nb][e];
                        s += __shfl_xor(s, 1); s += __shfl_xor(s, 2); s += __shfl_xor(s, 4); s += __shfl_xor(s, 8);
                        if (fr == 0) red[(ob * 16 + 4 * fq + e) * 8 + wave] = s;
                    }
                __syncthreads();
                float gmv[4];
#pragma unroll
                for (int nb = 0; nb < 4; ++nb) gmv[nb] = gmix[1536 + 64 * wave + nb * 16 + fr];
#pragma unroll
                for (int ob = 0; ob < 4; ++ob)
#pragma unroll
                    for (int e = 0; e < 4; ++e) {
                        const int k2 = ob * 16 + 4 * fq + e;
                        const LAS f32x4* rp = (const LAS f32x4*)(red + k2 * 8); const f32x4 ra = rp[0], rb = rp[1];
                        const float tot = ((ra.x + ra.y) + (ra.z + ra.w)) + ((rb.x + rb.y) + (rb.z + rb.w));
                        const float rstd = 1.f / sqrtf(tot * (1.f / 512.f) + RMS_EPS);
                        bf16_t* orow = MIX + (size_t)(b * SEQ + k1 + 64 * k2) * D + 1536 + 64 * wave + fr;
#pragma unroll
                        for (int nb = 0; nb < 4; ++nb) orow[nb * 16] = f2bf(acc[ob][nb][e] * rstd * gmv[nb]);
                    }
                __syncthreads();
            }
        }
        grid.sync();
        if (PH(4)) {
            pg8::Gemm g{MIX, (const bf16_t*)(ws + WS_WO) + (size_t)l * D * D, M, D, D, D}; pg8::StaticOrder S; S.init(M, D, G, bid);
            pg8::EpiRes E{X, D, ALPHA};
            pg8::gemm_phase<pg8::EpiRes, true>(lds, g, S, E);
        }
        grid.sync();
        if (PH(5)) { const int lane = launder(tid0) & 63; for (int m = gw; m < M; m += NGW) ln_row(X + (size_t)m * D, args.in[10] + (size_t)l * D, args.in[11] + (size_t)l * D, X + (size_t)m * D, XB + (size_t)m * D, lane); }
        grid.sync();
        if (PH(6)) {
            pg8::Gemm g{XB, (const bf16_t*)(ws + WS_WGU) + (size_t)l * NGU * D, M, NGU, D, D}; pg8::StaticOrder S; S.init(M, NGU, G, bid);
            pg8::EpiBf16 E{GU, NGU};
            pg8::gemm_phase<pg8::EpiBf16, true>(lds, g, S, E);
        }
        grid.sync();
        if (PH(7)) {
            const int tid = launder(tid0);
            const float* cw = args.in[14] + (size_t)l * 3 * DFF; const float* cb = args.in[15] + (size_t)l * DFF;
            constexpr int NCH = DFF / 8, NRUN = M / 16;
            for (int idx = bid * 512 + tid; idx < NCH * NRUN; idx += G * 512) {
                const int ch = idx % NCH, run = idx / NCH, r0 = run * 16, t0 = r0 & (SEQ - 1), c0 = ch * 8;
                float w0[8], w1[8], w2[8], bb[8];
#pragma unroll
                for (int j = 0; j < 8; ++j) { w0[j] = cw[c0 + j]; w1[j] = cw[DFF + c0 + j]; w2[j] = cw[2 * DFF + c0 + j]; bb[j] = cb[c0 + j]; }
                float gp[8], gc[8], gn[8];
                if (t0 > 0) unpack8(*(const u32x4*)(GU + (size_t)(r0 - 1) * NGU + c0), gp); else {
#pragma unroll
                    for (int j = 0; j < 8; ++j) gp[j] = 0.f; }
                unpack8(*(const u32x4*)(GU + (size_t)r0 * NGU + c0), gc);
                for (int i = 0; i < 16; ++i) {
                    const int r = r0 + i;
                    if (t0 + i < SEQ - 1) unpack8(*(const u32x4*)(GU + (size_t)(r + 1) * NGU + c0), gn); else {
#pragma unroll
                        for (int j = 0; j < 8; ++j) gn[j] = 0.f; }
                    float uu[8]; unpack8(*(const u32x4*)(GU + (size_t)r * NGU + DFF + c0), uu);
                    float o[8];
#pragma unroll
                    for (int j = 0; j < 8; ++j) { const float y = w0[j] * gp[j] + w1[j] * gc[j] + w2[j] * gn[j] + bb[j]; o[j] = 0.5f * y * (1.f + erff(y * 0.70710678118654752f)) * uu[j]; }
                    u32x4 w; w.x = cvt_pk_bf16(o[0], o[1]); w.y = cvt_pk_bf16(o[2], o[3]); w.z = cvt_pk_bf16(o[4], o[5]); w.w = cvt_pk_bf16(o[6], o[7]);
                    *(u32x4*)(GU + (size_t)r * NGU + DFF + c0) = w;
#pragma unroll
                    for (int j = 0; j < 8; ++j) { gp[j] = gc[j]; gc[j] = gn[j]; }
                }
            }
        }
        grid.sync();
        if (PH(8)) {
            pg8::Gemm g{GU + DFF, (const bf16_t*)(ws + WS_WD) + (size_t)l * D * DFF, M, D, DFF, NGU}; pg8::StaticOrder S; S.init(M, D, G, bid);
            pg8::EpiRes E{X, D, ALPHA};
            pg8::gemm_phase<pg8::EpiRes, true>(lds, g, S, E);
        }
        grid.sync();
        if (PH(9)) { const int lane = launder(tid0) & 63; for (int m = gw; m < M; m += NGW) ln_row(X + (size_t)m * D, args.in[17] + (size_t)l * D, args.in[18] + (size_t)l * D, X + (size_t)m * D, XB + (size_t)m * D, lane); }
        grid.sync();
    }
}

extern "C" void kernel_launch(void* const* d_in, const int* in_sizes, int n_in, void* d_out, int out_size, void* d_ws, size_t ws_size, hipStream_t stream) {
    static int grid_blocks = 0;
    if (grid_blocks == 0) {
        if (n_in != 19 || out_size != M * D || ws_size < WS_END) { fprintf(stderr, "kernel_launch: unexpected shapes (n_in %d, out %d, ws %zu, need %zu)\n", n_in, out_size, ws_size, (size_t)WS_END); grid_blocks = -1; return; }
        int dev = 0, cus = 0, per_cu = 0;
        (void)hipGetDevice(&dev);
        (void)hipDeviceGetAttribute(&cus, hipDeviceAttributeMultiprocessorCount, dev);
        if (hipFuncSetAttribute((const void*)fwd_kernel, hipFuncAttributeMaxDynamicSharedMemorySize, LDS_BYTES) != hipSuccess) { fprintf(stderr, "kernel_launch: hipFuncSetAttribute failed\n"); grid_blocks = -1; return; }
        if (hipOccupancyMaxActiveBlocksPerMultiprocessor(&per_cu, (const void*)fwd_kernel, 512, LDS_BYTES) != hipSuccess || per_cu < 1) { fprintf(stderr, "kernel_launch: occupancy query failed (%d)\n", per_cu); (void)hipGetLastError(); per_cu = 1; }
        grid_blocks = cus * per_cu;
        if (grid_blocks > 256) grid_blocks = 256;
    }
    if (grid_blocks < 0) return;
    Args a{};
    for (int i = 0; i < 19; ++i) a.in[i] = (const float*)d_in[i];
    a.out = (float*)d_out; a.ws = (unsigned char*)d_ws;
    void* kargs[] = {&a};
    hipError_t e = hipLaunchCooperativeKernel((const void*)fwd_kernel, dim3(grid_blocks), dim3(512), kargs, LDS_BYTES, stream);
    if (e != hipSuccess) fprintf(stderr, "cooperative launch failed: %s (grid %d)\n", hipGetErrorString(e), grid_blocks);
}
```

```cpp
#include <hip/hip_runtime.h>
#include <hip/hip_cooperative_groups.h>
#include <cstdio>
#include <cstdint>
namespace cg = cooperative_groups;

#define LAS __attribute__((address_space(3)))
typedef unsigned short bf16_t;
typedef short bf16x8 __attribute__((ext_vector_type(8)));
typedef short s16x4 __attribute__((ext_vector_type(4)));
typedef float f32x4 __attribute__((ext_vector_type(4)));
typedef float f32x2 __attribute__((ext_vector_type(2)));
typedef unsigned u32x4 __attribute__((ext_vector_type(4)));
typedef unsigned u32x2 __attribute__((ext_vector_type(2)));

constexpr int D = 2048, BATCH = 8, SEQ = 4096, DEPTH = 2, M = BATCH * SEQ;
constexpr int NZ = 4608;
constexpr int ZC_GB = 0, ZC_GC = 1024, ZC_V = 2048, ZC_POOL = 3072, ZC_FR = 3584, ZC_FI = 4096;
constexpr int DFF = 5632, NGU = 2 * DFF;
constexpr float ALPHA = 1.4142135623730951f;
constexpr float LN_EPS = 1e-5f, RMS_EPS = 1e-6f;

constexpr size_t MiB = 1u << 20;
constexpr size_t WS_WIN = 0;
constexpr size_t WS_WO = 36 * MiB;
constexpr size_t WS_WGU = 52 * MiB;
constexpr size_t WS_WD = 140 * MiB;
constexpr size_t WS_PW = 184 * MiB;
constexpr size_t WS_XB = 185 * MiB;
constexpr size_t WS_BIG = 313 * MiB;
constexpr size_t WS_Z = WS_BIG;
constexpr size_t WS_MIX = WS_BIG + 288 * MiB;
constexpr size_t WS_YP = WS_BIG + 416 * MiB;
constexpr size_t WS_END = WS_BIG + 704 * MiB;

#ifndef PHMASK
#define PHMASK 0xFFFF
#endif
#define PH(n) ((PHMASK >> (n)) & 1)
constexpr int LDS_BYTES = 155648;

__device__ __forceinline__ unsigned cvt_pk_bf16(float lo, float hi) { unsigned r; asm volatile("v_cvt_pk_bf16_f32 %0, %1, %2" : "=v"(r) : "v"(lo), "v"(hi)); return r; }
__device__ __forceinline__ bf16_t f2bf(float x) { return (bf16_t)(cvt_pk_bf16(x, 0.f) & 0xffffu); }
__device__ __forceinline__ float bf_lo(unsigned w) { return __uint_as_float(w << 16); }
__device__ __forceinline__ float bf_hi(unsigned w) { return __uint_as_float(w & 0xffff0000u); }
__device__ __forceinline__ float bf2f(bf16_t b) { return __uint_as_float(((unsigned)b) << 16); }
__device__ __forceinline__ void unpack8(const u32x4 w, float (&f)[8]) {
    f[0] = bf_lo(w.x); f[1] = bf_hi(w.x); f[2] = bf_lo(w.y); f[3] = bf_hi(w.y); f[4] = bf_lo(w.z); f[5] = bf_hi(w.z); f[6] = bf_lo(w.w); f[7] = bf_hi(w.w);
}
__device__ __forceinline__ int launder(int x) { asm volatile("" : "+v"(x)); return x; }
__device__ __forceinline__ float wave_sum(float v) {
#pragma unroll
    for (int o = 1; o < 64; o <<= 1) v += __shfl_xor(v, o);
    return v;
}

namespace pg8 {
constexpr int BM = 256, BK = 64, HALF = 128, HTB = HALF * BK * 2, STAGE_BYTES = 8 * HTB, NXCD = 8, WGM = 8;
__host__ __device__ __forceinline__ int lds_byte(int r, int c) { const int st = (r >> 4) * 2 + (c >> 5), rr = r & 15, cc = c & 31, ob = rr * 64 + cc * 2; return st * 1024 + (ob ^ (((ob >> 9) & 1) << 5)); }
__host__ __device__ __forceinline__ void stage_rc(int b, int& R, int& C) { const int st = b / 1024, sb = b % 1024, swz = sb ^ (((sb >> 9) & 1) << 5); R = (st >> 1) * 16 + swz / 64; C = (st & 1) * 32 + (swz % 64) / 2; }
__host__ __device__ __forceinline__ int perm32(int rho) { const int n = rho >> 4, i = rho & 15; return 8 * (i >> 2) + 4 * n + (i & 3); }

struct Unit { int pm, pn; };
struct Gemm { const bf16_t* A; const bf16_t* Bt; int M, N, K, lda; };

struct StaticOrder {
    int nM, nN, nwg, G, c;
    __device__ void init(int M_, int N_, int G_, int c_) { nM = M_ / BM; nN = N_ / BM; nwg = nM * nN; G = G_; c = c_; }
    __device__ bool next(int i, Unit& u) const {
        const long L = (long)i * G + c; if (L >= nwg) return false;
        int wgid = (int)L; { const int q = nwg / NXCD, r = nwg % NXCD, xcd = wgid % NXCD, off = wgid / NXCD; wgid = (xcd < r ? xcd * (q + 1) : r * (q + 1) + (xcd - r) * q) + off; }
        const int nig = WGM * nN, gid = wgid / nig, fm = gid * WGM, gsz = (nM - fm) < WGM ? (nM - fm) : WGM;
        u.pm = fm + ((wgid % nig) % gsz); u.pn = (wgid % nig) / gsz; return true;
    }
};

struct EpiBf16 {
    static constexpr bool PERM = true;
    bf16_t* O; int ldc;
    __device__ __forceinline__ void operator()(const f32x4 (&acc)[2][2][4][2], const Unit& u, int wr, int wc, int fr, int fq) const {
        const int row0 = u.pm * BM + wr * 64 + fr; const int col0 = u.pn * BM + wc * 32 + 8 * fq;
#pragma unroll
        for (int ai = 0; ai < 2; ++ai)
#pragma unroll
            for (int m = 0; m < 4; ++m) { bf16_t* rowp = O + (size_t)(row0 + ai * HALF + m * 16) * ldc + col0;
#pragma unroll
                for (int bj = 0; bj < 2; ++bj) { const f32x4 v0 = acc[ai][bj][m][0], v1 = acc[ai][bj][m][1];
                    u32x4 w; w.x = cvt_pk_bf16(v0[0], v0[1]); w.y = cvt_pk_bf16(v0[2], v0[3]); w.z = cvt_pk_bf16(v1[0], v1[1]); w.w = cvt_pk_bf16(v1[2], v1[3]);
                    *(u32x4*)(rowp + bj * HALF) = w; } }
    }
};
struct EpiRes {
    static constexpr bool PERM = false;
    float* X; int ldc; float alpha;
    __device__ __forceinline__ void operator()(const f32x4 (&acc)[2][2][4][2], const Unit& u, int wr, int wc, int fr, int fq) const {
        const int row0 = u.pm * BM + wr * 64 + fr, col0 = u.pn * BM + wc * 32 + 4 * fq;
#pragma unroll
        for (int ai = 0; ai < 2; ++ai)
#pragma unroll
            for (int m = 0; m < 4; ++m) { float* rowp = X + (size_t)(row0 + ai * HALF + m * 16) * ldc + col0;
#pragma unroll
                for (int bj = 0; bj < 2; ++bj)
#pragma unroll
                    for (int n = 0; n < 2; ++n) { f32x4* p = (f32x4*)(rowp + bj * HALF + n * 16); const f32x4 xv = *p; *p = xv * alpha + acc[ai][bj][m][n]; }
                asm volatile("" ::: "memory"); }
    }
};

template <class Epi, bool ALIGN_EPI>
__device__ __forceinline__ void gemm_phase(LAS unsigned char* lds, const Gemm g, const StaticOrder& S, const Epi& E) {
    const int tid = launder(threadIdx.x), wid = __builtin_amdgcn_readfirstlane(tid >> 6), lane = tid & 63, wr = wid >> 2, wc = wid & 3, fr = lane & 15, fq = lane >> 4;
    const int K = g.K, nt = K / BK, lda = g.lda;
    unsigned voffA[2], voffB[2];
#pragma unroll
    for (int i = 0; i < 2; ++i) { int R, C; stage_rc(tid * 16 + i * 8192, R, C); const int Rb = Epi::PERM ? ((R & ~31) + perm32(R & 31)) : R;
        voffA[i] = (unsigned)(R * lda + C) * 2u; voffB[i] = (unsigned)(Rb * K + C) * 2u; }
    const size_t kstep = (size_t)(BK * 2);
    const size_t hstepA = (size_t)HALF * lda * 2, hstepB = (size_t)HALF * K * 2;
    const size_t tstepA = 2 * hstepA, tstepB = 2 * hstepB;
    const unsigned ldsw = (unsigned)wid * 1024u;
    const int aoff = lds_byte(wr * 64 + fr, fq * 8), boff = lds_byte(wc * 32 + fr, fq * 8);
#define PG8_SA(b, h) (((b) * 2 + (h)) * HTB)
#define PG8_SB(b, h) ((4 + (b) * 2 + (h)) * HTB)
#define PG8_STAGE(bufoff, gbase, voff) do { _Pragma("unroll") for (int _i = 0; _i < 2; ++_i) \
        __builtin_amdgcn_global_load_lds((const unsigned*)((const char*)(gbase) + (voff)[_i]), (LAS unsigned*)(lds + (bufoff) + ldsw + _i * 8192), 16, 0, 0); } while (0)
#define PG8_LDA(dst, b, h) do { _Pragma("unroll") for (int m = 0; m < 4; ++m) _Pragma("unroll") for (int k = 0; k < 2; ++k) dst[m][k] = *(const LAS bf16x8*)(lds + PG8_SA(b, h) + aoff + m * 2048 + k * 1024); } while (0)
#define PG8_LDB(dst, b, h) do { _Pragma("unroll") for (int n = 0; n < 2; ++n) _Pragma("unroll") for (int k = 0; k < 2; ++k) dst[n][k] = *(const LAS bf16x8*)(lds + PG8_SB(b, h) + boff + n * 2048 + k * 1024); } while (0)
#define PG8_MMA(ai, bj, At, Bt) do { __builtin_amdgcn_s_setprio(1); _Pragma("unroll") for (int m = 0; m < 4; ++m) _Pragma("unroll") for (int n = 0; n < 2; ++n) _Pragma("unroll") for (int k = 0; k < 2; ++k) \
        acc[ai][bj][m][n] = __builtin_amdgcn_mfma_f32_16x16x32_bf16(Bt[n][k], At[m][k], acc[ai][bj][m][n], 0, 0, 0); __builtin_amdgcn_s_setprio(0); } while (0)
#define PG8_WAIT_V(n) asm volatile("s_waitcnt vmcnt(" #n ")" ::: "memory")
#define PG8_WAIT_L(n) asm volatile("s_waitcnt lgkmcnt(" #n ")" ::: "memory")
#define PG8_BAR __builtin_amdgcn_s_barrier()
#define PG8_SCHED __builtin_amdgcn_sched_barrier(0)
    Unit cur, nxt; int ui = 0;
    if (!S.next(0, cur)) return;
    f32x4 acc[2][2][4][2];
#pragma unroll
    for (int a = 0; a < 2; ++a)
#pragma unroll
        for (int b = 0; b < 2; ++b)
#pragma unroll
            for (int m = 0; m < 4; ++m)
#pragma unroll
                for (int n = 0; n < 2; ++n) acc[a][b][m][n] = (f32x4){0.f, 0.f, 0.f, 0.f};
    bf16x8 At[4][2], B0[2][2], B1[2][2];
    const char* cA = (const char*)g.A + (size_t)cur.pm * tstepA; const char* cB = (const char*)g.Bt + (size_t)cur.pn * tstepB;
    PG8_STAGE(PG8_SB(0, 0), cB, voffB); PG8_STAGE(PG8_SB(0, 1), cB + hstepB, voffB); PG8_STAGE(PG8_SA(0, 0), cA, voffA); PG8_STAGE(PG8_SA(0, 1), cA + hstepA, voffA);
    if (wr == 1) PG8_BAR;
    PG8_WAIT_V(2); PG8_BAR;
    PG8_STAGE(PG8_SB(1, 0), cB + kstep, voffB); PG8_STAGE(PG8_SA(1, 0), cA + kstep, voffA); PG8_STAGE(PG8_SB(1, 1), cB + hstepB + kstep, voffB);
    PG8_WAIT_V(6); PG8_BAR;
    for (;;) {
        const bool has_next = S.next(ui + 1, nxt);
        const char* nA = has_next ? (const char*)g.A + (size_t)nxt.pm * tstepA : cA; const char* nB = has_next ? (const char*)g.Bt + (size_t)nxt.pn * tstepB : cB;
        for (int t = 0; t < nt; t += 2) {
            const bool last = (t == nt - 2);
            const char* a1 = cA + (size_t)(t + 1) * kstep;
            const char* a2 = last ? nA : cA + (size_t)(t + 2) * kstep; const char* b2 = last ? nB : cB + (size_t)(t + 2) * kstep;
            const char* a3 = a2 + kstep; const char* b3 = b2 + kstep;
            PG8_LDB(B0, 0, 0); PG8_LDB(B1, 0, 1); PG8_SCHED; PG8_LDA(At, 0, 0); PG8_STAGE(PG8_SA(1, 1), a1 + hstepA, voffA);
            PG8_WAIT_V(8); PG8_WAIT_L(0); PG8_BAR; PG8_MMA(0, 0, At, B0); PG8_MMA(0, 1, At, B1); PG8_BAR; PG8_SCHED;
            PG8_LDA(At, 0, 1); PG8_STAGE(PG8_SB(0, 0), b2, voffB); PG8_STAGE(PG8_SB(0, 1), b2 + hstepB, voffB); PG8_STAGE(PG8_SA(0, 0), a2, voffA);
            PG8_WAIT_V(8); PG8_WAIT_L(0); PG8_BAR; PG8_MMA(1, 0, At, B0); PG8_MMA(1, 1, At, B1); PG8_BAR; PG8_SCHED;
            PG8_LDB(B0, 1, 0); PG8_LDB(B1, 1, 1); PG8_SCHED; PG8_LDA(At, 1, 0); PG8_STAGE(PG8_SA(0, 1), a2 + hstepA, voffA);
            PG8_WAIT_V(8); PG8_WAIT_L(0); PG8_BAR; PG8_MMA(0, 0, At, B0); PG8_MMA(0, 1, At, B1); PG8_BAR; PG8_SCHED;
            PG8_LDA(At, 1, 1); PG8_STAGE(PG8_SB(1, 0), b3, voffB); PG8_STAGE(PG8_SB(1, 1), b3 + hstepB, voffB); PG8_STAGE(PG8_SA(1, 0), a3, voffA);
            PG8_WAIT_V(8); PG8_WAIT_L(0); PG8_BAR; PG8_MMA(1, 0, At, B0); PG8_MMA(1, 1, At, B1); PG8_BAR; PG8_SCHED;
        }
        if constexpr (ALIGN_EPI) { if (wr == 0) PG8_BAR; }
        E(acc, cur, wr, wc, fr, fq);
        if (!has_next) break;
#pragma unroll
        for (int a = 0; a < 2; ++a)
#pragma unroll
            for (int b = 0; b < 2; ++b)
#pragma unroll
                for (int m = 0; m < 4; ++m)
#pragma unroll
                    for (int n = 0; n < 2; ++n) acc[a][b][m][n] = (f32x4){0.f, 0.f, 0.f, 0.f};
        cur = nxt; cA = nA; cB = nB; ++ui;
        if constexpr (ALIGN_EPI) { if (wr == 1) PG8_BAR; }
    }
    PG8_WAIT_V(0);
    if constexpr (!ALIGN_EPI) { if (wr == 0) PG8_BAR; }
    PG8_BAR;
#undef PG8_SA
#undef PG8_SB
#undef PG8_STAGE
#undef PG8_LDA
#undef PG8_LDB
#undef PG8_MMA
#undef PG8_WAIT_V
#undef PG8_WAIT_L
#undef PG8_BAR
#undef PG8_SCHED
}
}

struct Args { const float* in[19]; float* out; unsigned char* ws; };

#define LDS_WAIT() asm volatile("s_waitcnt lgkmcnt(0)" ::: "memory")

__device__ __forceinline__ void p0_transpose_item(const float* W, int K, int pitch, int nblk, bf16_t* WT, int row_off, LAS float* scr, int item, int lane) {
    const int kb = item / nblk, nb = item % nblk, k0 = 64 * kb, n0 = 32 * nb;
#pragma unroll 8
    for (int i = 0; i < 32; ++i) { const int kk = 2 * i + (lane >> 5); scr[kk * 33 + (lane & 31)] = W[(size_t)(k0 + kk) * pitch + n0 + (lane & 31)]; }
    LDS_WAIT(); asm volatile("" ::: "memory");
    const int c = lane & 7;
#pragma unroll
    for (int j = 0; j < 4; ++j) { const int n = (lane >> 3) + 8 * j; const LAS float* s = scr + (8 * c) * 33 + n;
        u32x4 o; o.x = cvt_pk_bf16(s[0 * 33], s[1 * 33]); o.y = cvt_pk_bf16(s[2 * 33], s[3 * 33]); o.z = cvt_pk_bf16(s[4 * 33], s[5 * 33]); o.w = cvt_pk_bf16(s[6 * 33], s[7 * 33]);
        *(u32x4*)(WT + (size_t)(row_off + n0 + n) * K + k0 + 8 * c) = o; }
    LDS_WAIT(); asm volatile("" ::: "memory");
}

template <bool ADD>
__device__ __forceinline__ void ln_row(const float* xrow, const bf16_t* yrow, const float* g, const float* b, float* orow, bf16_t* obrow, int lane) {
    const f32x4* xr = (const f32x4*)xrow + lane;
    f32x4 v[8]; float s = 0.f;
    if (ADD) {
        const u32x2* yr = (const u32x2*)yrow + lane; u32x2 yv[8];
#pragma unroll
        for (int j = 0; j < 8; ++j) { v[j] = xr[64 * j]; yv[j] = yr[64 * j]; }
#pragma unroll
        for (int j = 0; j < 8; ++j) { v[j] = v[j] * ALPHA + (f32x4){bf_lo(yv[j].x), bf_hi(yv[j].x), bf_lo(yv[j].y), bf_hi(yv[j].y)}; s += (v[j].x + v[j].y) + (v[j].z + v[j].w); }
    } else {
#pragma unroll
    for (int j = 0; j < 8; ++j) { v[j] = xr[64 * j]; s += (v[j].x + v[j].y) + (v[j].z + v[j].w); }
    }
    const float mean = wave_sum(s) * (1.f / D); float s2 = 0.f;
#pragma unroll
    for (int j = 0; j < 8; ++j) { v[j] = v[j] - mean; s2 += (v[j].x * v[j].x + v[j].y * v[j].y) + (v[j].z * v[j].z + v[j].w * v[j].w); }
    const float rstd = 1.f / sqrtf(wave_sum(s2) * (1.f / D) + LN_EPS);
    const f32x4* gp = (const f32x4*)g + lane; const f32x4* bp = (const f32x4*)b + lane;
    f32x4* op = (f32x4*)orow + lane; u32x2* ob = (u32x2*)obrow + lane;
#pragma unroll
    for (int j = 0; j < 8; ++j) { const f32x4 o = v[j] * rstd * gp[64 * j] + bp[64 * j]; op[64 * j] = o;
        u32x2 w; w.x = cvt_pk_bf16(o.x, o.y); w.y = cvt_pk_bf16(o.z, o.w); ob[64 * j] = w; }
}

__global__ void __launch_bounds__(512, 2) fwd_kernel(Args args) {
    extern __shared__ __attribute__((aligned(16))) unsigned char lds_raw[];
    LAS unsigned char* lds = (LAS unsigned char*)lds_raw;
    cg::grid_group grid = cg::this_grid();
    const int tid0 = threadIdx.x, wave = __builtin_amdgcn_readfirstlane(tid0 >> 6);
    const int G = gridDim.x, bid = blockIdx.x;
    const int gw = bid * 8 + wave, NGW = G * 8;
    unsigned char* ws = args.ws;
    float* X = args.out;
    bf16_t* XB = (bf16_t*)(ws + WS_XB);
    bf16_t* Z = (bf16_t*)(ws + WS_Z);
    bf16_t* MIX = (bf16_t*)(ws + WS_MIX);
    bf16_t* YP = (bf16_t*)(ws + WS_YP);
    bf16_t* GU = (bf16_t*)(ws + WS_BIG);
    bf16_t* PWT = (bf16_t*)(ws + WS_PW);
    bf16_t* Y1 = (bf16_t*)(ws + WS_Z);

    if (PH(0)) {
        const int tid = launder(tid0), lane = tid & 63;
        for (int it = bid; it < 256; it += G) {
            const int l = it >> 7, h = (it >> 5) & 3, cs = (it >> 4) & 1, kc = it & 15;
            LAS float* CW = (LAS float*)lds;
            {
                const int c = tid >> 2, d0 = (tid & 3) * 32;
                float a[32];
#pragma unroll
                for (int j = 0; j < 32; ++j) a[j] = 0.f;
                const float* Wf = args.in[7] + ((size_t)(l * 4 + h) * 128) * 128 + d0;
                for (int cp = 0; cp < 128; ++cp) {
                    const float fr_ = (float)((c * cp) & 127) * (1.f / 128.f);
                    const float tw = cs ? -__builtin_amdgcn_sinf(fr_) : __builtin_amdgcn_cosf(fr_);
                    const f32x4* wr_ = (const f32x4*)(Wf + (size_t)cp * 128);
#pragma unroll
                    for (int j = 0; j < 8; ++j) { const f32x4 w = wr_[j]; a[4 * j] += tw * w.x; a[4 * j + 1] += tw * w.y; a[4 * j + 2] += tw * w.z; a[4 * j + 3] += tw * w.w; }
                }
#pragma unroll
                for (int j = 0; j < 32; ++j) CW[c * 128 + d0 + j] = a[j] * 0.08838834764831845f;
            }
            __syncthreads();
            {
                const int k = kc * 128 + (tid & 127), d0 = (tid >> 7) * 32;
                float a[32];
#pragma unroll
                for (int j = 0; j < 32; ++j) a[j] = 0.f;
                const float* wrow = args.in[3] + ((size_t)l * D + k) * 4096 + 3584 + h * 128;
                for (int c4 = 0; c4 < 32; ++c4) {
                    const f32x4 wv = *(const f32x4*)(wrow + 4 * c4);
#pragma unroll
                    for (int cc = 0; cc < 4; ++cc) { const float av = wv[cc]; const LAS f32x4* cwp = (const LAS f32x4*)(CW + (4 * c4 + cc) * 128 + d0);
#pragma unroll
                        for (int j = 0; j < 8; ++j) { const f32x4 w = cwp[j]; a[4 * j] += av * w.x; a[4 * j + 1] += av * w.y; a[4 * j + 2] += av * w.z; a[4 * j + 3] += av * w.w; } }
                }
                bf16_t* dst = (bf16_t*)(ws + WS_WIN) + ((size_t)l * NZ + ZC_FR + cs * 512 + h * 128 + d0) * D + k;
#pragma unroll
                for (int j = 0; j < 32; ++j) dst[(size_t)j * D] = f2bf(a[j]);
            }
            __syncthreads();
        }
        {
            LAS float* scr = (LAS float*)(lds + wave * 16384);
            constexpr int I_IN = 32 * 112, I_O = 32 * 64, I_G = 32 * 176, I_D = 88 * 64, I_L = I_IN + I_O + 2 * I_G + I_D;
            for (int it = gw; it < 2 * I_L; it += NGW) {
                const int l = it / I_L; int r = it - l * I_L;
                if (r < I_IN) { p0_transpose_item(args.in[3] + (size_t)l * D * 4096, D, 4096, 112, (bf16_t*)(ws + WS_WIN) + (size_t)l * NZ * D, 0, scr, r, lane); continue; } r -= I_IN;
                if (r < I_O) { p0_transpose_item(args.in[9] + (size_t)l * D * D, D, D, 64, (bf16_t*)(ws + WS_WO) + (size_t)l * D * D, 0, scr, r, lane); continue; } r -= I_O;
                if (r < I_G) { p0_transpose_item(args.in[12] + (size_t)l * D * DFF, D, DFF, 176, (bf16_t*)(ws + WS_WGU) + (size_t)l * NGU * D, 0, scr, r, lane); continue; } r -= I_G;
                if (r < I_G) { p0_transpose_item(args.in[13] + (size_t)l * D * DFF, D, DFF, 176, (bf16_t*)(ws + WS_WGU) + (size_t)l * NGU * D, DFF, scr, r, lane); continue; } r -= I_G;
                p0_transpose_item(args.in[16] + (size_t)l * DFF * D, DFF, D, 64, (bf16_t*)(ws + WS_WD) + (size_t)l * D * DFF, 0, scr, r, lane);
            }
        }
        for (int i = bid * 512 + tid; i < 2 * 4 * 128 * 128; i += G * 512) { const int c = i & 127, d = (i >> 7) & 127, lg = i >> 14; PWT[i] = f2bf(args.in[5][((size_t)lg * 128 + c) * 128 + d]); }
        for (int m = gw; m < M; m += NGW) ln_row<false>(args.in[0] + (size_t)m * D, nullptr, args.in[1], args.in[2], X + (size_t)m * D, XB + (size_t)m * D, lane);
    }
    grid.sync();

    for (int l = 0; l < DEPTH; ++l) {
        if (PH(1)) {
            pg8::Gemm g{XB, (const bf16_t*)(ws + WS_WIN) + (size_t)l * NZ * D, M, NZ, D, D}; pg8::StaticOrder S; S.init(M, NZ, G, bid);
            pg8::EpiBf16 E{Z, NZ};
            pg8::gemm_phase<pg8::EpiBf16, true>(lds, g, S, E);
        }
        grid.sync();
        if (PH(2)) {
            const int tid = launder(tid0), lane = tid & 63;
            const float* gmix = args.in[8] + (size_t)l * D;
            LAS unsigned char* M1p = lds;
            LAS unsigned char* tile = lds + 128 * 272;
            for (int i = tid; i < 128 * 128; i += 512) {
                const int o = i >> 7, ks_ = (i >> 5) & 3, kq = (i >> 3) & 3, e = (i >> 2) & 1, q = i & 3;
                const int ro = o >> 6, k1 = o & 63, ri = ks_ >> 1, t1 = (ks_ & 1) * 32 + 16 * e + 4 * kq + q;
                const float fr_ = (float)((k1 * t1) & 63) * (1.f / 64.f);
                const float c = __builtin_amdgcn_cosf(fr_) * 0.125f, s = __builtin_amdgcn_sinf(fr_) * 0.125f;
                const float v = (ro == ri) ? c : (ro == 0 ? s : -s);
                *(LAS bf16_t*)(M1p + o * 272 + (i & 127) * 2) = f2bf(v);
            }
            __syncthreads();
            const int fr = lane & 15, fq = lane >> 4, qq = fr >> 2, pp = fr & 3;
            for (int it = bid; it < 1024; it += G) {
                const int b = it >> 7, t2 = (it >> 1) & 63, half = it & 1;
#pragma unroll
                for (int i = 0; i < 8; ++i) { const int idx = tid + 512 * i, row = idx >> 6, ch = idx & 63, ri = ch >> 5, cc = ch & 31;
                    const u32x4 v = *(const u32x4*)(Z + (size_t)(b * SEQ + 64 * row + t2) * NZ + ZC_FR + ri * 512 + half * 256 + cc * 8);
                    *(LAS u32x4*)(tile + row * 1056 + ri * 512 + cc * 16) = v; }
                __syncthreads();
                f32x4 acc[8][2];
#pragma unroll
                for (int a = 0; a < 8; ++a) { acc[a][0] = (f32x4){0.f, 0.f, 0.f, 0.f}; acc[a][1] = (f32x4){0.f, 0.f, 0.f, 0.f}; }
#pragma unroll
                for (int ks_ = 0; ks_ < 4; ++ks_) {
                    const int ri = ks_ >> 1, T0 = (ks_ & 1) * 32;
                    bf16x8 bfrag[2];
#pragma unroll
                    for (int nb = 0; nb < 2; ++nb) {
                        const int cb = (ri * 256 + 32 * wave + nb * 16 + 4 * pp) * 2;
                        const s16x4 lo = __builtin_amdgcn_ds_read_tr16_b64_v4i16((LAS s16x4*)(tile + (T0 + 4 * fq + qq) * 1056 + cb));
                        const s16x4 hi = __builtin_amdgcn_ds_read_tr16_b64_v4i16((LAS s16x4*)(tile + (T0 + 16 + 4 * fq + qq) * 1056 + cb));
                        bfrag[nb] = (bf16x8){lo.x, lo.y, lo.z, lo.w, hi.x, hi.y, hi.z, hi.w};
                    }
#pragma unroll
                    for (int ob = 0; ob < 8; ++ob) {
                        const bf16x8 af = *(const LAS bf16x8*)(M1p + (ob * 16 + fr) * 272 + (ks_ * 32 + fq * 8) * 2);
                        acc[ob][0] = __builtin_amdgcn_mfma_f32_16x16x32_bf16(af, bfrag[0], acc[ob][0], 0, 0, 0);
                        acc[ob][1] = __builtin_amdgcn_mfma_f32_16x16x32_bf16(af, bfrag[1], acc[ob][1], 0, 0, 0);
                    }
                }
#pragma unroll
                for (int ob = 0; ob < 4; ++ob)
#pragma unroll
                    for (int e = 0; e < 4; ++e) {
                        const int k1 = ob * 16 + 4 * fq + e;
                        const float fr_ = (float)(k1 * t2) * (1.f / 4096.f);
                        const float ct = __builtin_amdgcn_cosf(fr_), st = __builtin_amdgcn_sinf(fr_);
                        bf16_t* dst = YP + ((size_t)((b * 64 + k1) * 64 + t2)) * 1024 + half * 256 + 32 * wave + fr;
#pragma unroll
                        for (int nb = 0; nb < 2; ++nb) {
                            const float yr = acc[ob][nb][e], yi = acc[ob + 4][nb][e];
                            dst[nb * 16] = f2bf(yr * ct + yi * st);
                            dst[512 + nb * 16] = f2bf(yi * ct - yr * st);
                        }
                    }
                __syncthreads();
            }
            {
                LAS unsigned char* Ht = lds;
                LAS unsigned char* Pt = lds + 48 * 1040;
                LAS float* red = (LAS float*)(lds + 48 * 1040 + 32 * 1040);
                const bf16_t* pw = PWT + (size_t)l * 4 * 128 * 128;
                const float* pscale = args.in[6] + (size_t)l * 512;
                const int g_ = wave >> 1, dh = wave & 1;
                for (int it = bid; it < M / 32; it += G) {
                    const int r0 = it * 32, t0 = r0 & (SEQ - 1);
#pragma unroll
                    for (int i = 0; i < 6; ++i) { const int idx = tid + 512 * i, row = idx >> 6, ch = idx & 63; const int t = t0 - 8 + row;
                        u32x4 v = (u32x4){0u, 0u, 0u, 0u};
                        if (t >= 0 && t < SEQ) v = *(const u32x4*)(Z + (size_t)(r0 - 8 + row) * NZ + ZC_POOL + ch * 8);
                        *(LAS u32x4*)(Ht + row * 1040 + ch * 16) = v; }
                    __syncthreads();
                    {
                        const int c = tid, gi = c >> 7, hf = 1 << gi;
                        float s = 0.f;
                        for (int j = -hf; j < hf; ++j) s += bf2f(*(const LAS bf16_t*)(Ht + (8 + j) * 1040 + c * 2));
                        for (int tt = 0; tt < 32; ++tt) {
                            const int t = t0 + tt;
                            const int hi_ = (t + hf < SEQ) ? t + hf : SEQ, lo_ = (t - hf > 0) ? t - hf : 0;
                            const float cnt = (float)(hi_ - lo_);
                            const float hc = bf2f(*(const LAS bf16_t*)(Ht + (8 + tt) * 1040 + c * 2));
                            *(LAS bf16_t*)(Pt + tt * 1040 + c * 2) = f2bf(s / cnt - hc);
                            s += bf2f(*(const LAS bf16_t*)(Ht + (8 + tt + hf) * 1040 + c * 2)) - bf2f(*(const LAS bf16_t*)(Ht + (8 + tt - hf) * 1040 + c * 2));
                        }
                    }
                    __syncthreads();
                    f32x4 acc[2][4];
#pragma unroll
                    for (int a = 0; a < 2; ++a)
#pragma unroll
                        for (int n = 0; n < 4; ++n) acc[a][n] = (f32x4){0.f, 0.f, 0.f, 0.f};
#pragma unroll
                    for (int ks_ = 0; ks_ < 4; ++ks_) {
                        bf16x8 tf[2];
#pragma unroll
                        for (int mb = 0; mb < 2; ++mb) tf[mb] = *(const LAS bf16x8*)(Pt + (mb * 16 + fr) * 1040 + (g_ * 128 + ks_ * 32 + fq * 8) * 2);
#pragma unroll
                        for (int nb = 0; nb < 4; ++nb) {
                            const bf16x8 wf = *(const bf16x8*)(pw + ((size_t)(g_ * 128 + dh * 64 + nb * 16 + fr)) * 128 + ks_ * 32 + fq * 8);
                            acc[0][nb] = __builtin_amdgcn_mfma_f32_16x16x32_bf16(wf, tf[0], acc[0][nb], 0, 0, 0);
                            acc[1][nb] = __builtin_amdgcn_mfma_f32_16x16x32_bf16(wf, tf[1], acc[1][nb], 0, 0, 0);
                        }
                    }
                    float ssq[2] = {0.f, 0.f};
#pragma unroll
                    for (int nb = 0; nb < 4; ++nb) { const f32x4 sc = *(const f32x4*)(pscale + g_ * 128 + dh * 64 + nb * 16 + 4 * fq);
#pragma unroll
                        for (int mb = 0; mb < 2; ++mb) { acc[mb][nb] = acc[mb][nb] * sc; const f32x4 v = acc[mb][nb]; ssq[mb] += (v.x * v.x + v.y * v.y) + (v.z * v.z + v.w * v.w); } }
#pragma unroll
                    for (int mb = 0; mb < 2; ++mb) { ssq[mb] += __shfl_xor(ssq[mb], 16); ssq[mb] += __shfl_xor(ssq[mb], 32); if (fq == 0) red[(mb * 16 + fr) * 8 + wave] = ssq[mb]; }
                    __syncthreads();
#pragma unroll
                    for (int mb = 0; mb < 2; ++mb) {
                        const LAS f32x4* rp = (const LAS f32x4*)(red + (mb * 16 + fr) * 8); const f32x4 ra = rp[0], rb = rp[1];
                        const float tot = ((ra.x + ra.y) + (ra.z + ra.w)) + ((rb.x + rb.y) + (rb.z + rb.w));
                        const float rstd = 1.f / sqrtf(tot * (1.f / 512.f) + RMS_EPS);
                        bf16_t* orow = MIX + (size_t)(r0 + mb * 16 + fr) * D + 1024 + g_ * 128 + dh * 64 + 4 * fq;
#pragma unroll
                        for (int nb = 0; nb < 4; ++nb) { const f32x4 gm = *(const f32x4*)(gmix + 1024 + g_ * 128 + dh * 64 + nb * 16 + 4 * fq); const f32x4 o = acc[mb][nb] * rstd * gm;
                            u32x2 w; w.x = cvt_pk_bf16(o.x, o.y); w.y = cvt_pk_bf16(o.z, o.w); *(u32x2*)(orow + nb * 16) = w; }
                    }
                    __syncthreads();
                }
            }
            {
                const float* ca = args.in[4] + (size_t)l * 3 * 1024;
                float a0[16], a1[16], a2[16], gm[16];
#pragma unroll
                for (int h = 0; h < 2; ++h)
#pragma unroll
                    for (int j = 0; j < 8; ++j) { const int c = h * 512 + lane * 8 + j; a0[h * 8 + j] = ca[c]; a1[h * 8 + j] = ca[1024 + c]; a2[h * 8 + j] = ca[2048 + c]; gm[h * 8 + j] = gmix[c]; }
                for (int run = gw; run < M / 16; run += NGW) {
                    const int r0 = run * 16, t0 = r0 & (SEQ - 1);
                    float up[16], uc[16], un[16];
#define LOAD_U(dst, r) do { _Pragma("unroll") for (int h = 0; h < 2; ++h) { const bf16_t* zp = Z + (size_t)(r) * NZ + h * 512 + lane * 8; \
                        float c_[8], v_[8]; unpack8(*(const u32x4*)(zp + ZC_GC), c_); unpack8(*(const u32x4*)(zp + ZC_V), v_); \
                        _Pragma("unroll") for (int j = 0; j < 8; ++j) dst[h * 8 + j] = c_[j] * v_[j]; } } while (0)
                    if (t0 > 0) { LOAD_U(up, r0 - 1); } else {
#pragma unroll
                        for (int j = 0; j < 16; ++j) up[j] = 0.f; }
                    LOAD_U(uc, r0);
                    for (int i = 0; i < 16; ++i) {
                        const int r = r0 + i;
                        if (t0 + i < SEQ - 1) { LOAD_U(un, r + 1); } else {
#pragma unroll
                            for (int j = 0; j < 16; ++j) un[j] = 0.f; }
                        float y[16]; float ss = 0.f;
#pragma unroll
                        for (int h = 0; h < 2; ++h) { float gb[8]; unpack8(*(const u32x4*)(Z + (size_t)r * NZ + ZC_GB + h * 512 + lane * 8), gb);
#pragma unroll
                            for (int j = 0; j < 8; ++j) { const int k = h * 8 + j; y[k] = gb[j] * (a0[k] * up[k] + a1[k] * uc[k] + a2[k] * un[k]); ss += y[k] * y[k]; } }
                        const float rstd = 1.f / sqrtf(wave_sum(ss) * (1.f / 1024.f) + RMS_EPS);
#pragma unroll
                        for (int h = 0; h < 2; ++h) { u32x4 w;
                            w.x = cvt_pk_bf16(y[h * 8 + 0] * rstd * gm[h * 8 + 0], y[h * 8 + 1] * rstd * gm[h * 8 + 1]); w.y = cvt_pk_bf16(y[h * 8 + 2] * rstd * gm[h * 8 + 2], y[h * 8 + 3] * rstd * gm[h * 8 + 3]);
                            w.z = cvt_pk_bf16(y[h * 8 + 4] * rstd * gm[h * 8 + 4], y[h * 8 + 5] * rstd * gm[h * 8 + 5]); w.w = cvt_pk_bf16(y[h * 8 + 6] * rstd * gm[h * 8 + 6], y[h * 8 + 7] * rstd * gm[h * 8 + 7]);
                            *(u32x4*)(MIX + (size_t)r * D + h * 512 + lane * 8) = w; }
#pragma unroll
                        for (int j = 0; j < 16; ++j) { up[j] = uc[j]; uc[j] = un[j]; }
                    }
#undef LOAD_U
                }
            }
        }
        grid.sync();
        if (PH(3)) {
            const int tid = launder(tid0), lane = tid & 63;
            const float* gmix = args.in[8] + (size_t)l * D;
            LAS unsigned char* M2p = lds;
            LAS unsigned char* tile = lds + 64 * 272;
            LAS float* red = (LAS float*)(lds + 64 * 272 + 64 * 2080);
            for (int i = tid; i < 64 * 128; i += 512) {
                const int o = i >> 7, ks_ = (i >> 5) & 3, kq = (i >> 3) & 3, e = (i >> 2) & 1, q = i & 3;
                const int ri = ks_ >> 1, t2 = (ks_ & 1) * 32 + 16 * e + 4 * kq + q;
                const float fr_ = (float)((o * t2) & 63) * (1.f / 64.f);
                const float v = (ri == 0 ? __builtin_amdgcn_cosf(fr_) : __builtin_amdgcn_sinf(fr_)) * 0.125f;
                *(LAS bf16_t*)(M2p + o * 272 + (i & 127) * 2) = f2bf(v);
            }
            __syncthreads();
            const int fr = lane & 15, fq = lane >> 4, qq = fr >> 2, pp = fr & 3;
            for (int it = bid; it < 512; it += G) {
                const int b = it >> 6, k1 = it & 63;
                const bf16_t* src = YP + (size_t)((b * 64 + k1) * 64) * 1024;
#pragma unroll
                for (int i = 0; i < 16; ++i) { const int idx = tid + 512 * i, row = idx >> 7, ch = idx & 127;
                    *(LAS u32x4*)(tile + row * 2080 + ch * 16) = *(const u32x4*)(src + (size_t)row * 1024 + ch * 8); }
                __syncthreads();
                f32x4 acc[4][4];
#pragma unroll
                for (int a = 0; a < 4; ++a)
#pragma unroll
                    for (int n = 0; n < 4; ++n) acc[a][n] = (f32x4){0.f, 0.f, 0.f, 0.f};
#pragma unroll
                for (int ks_ = 0; ks_ < 4; ++ks_) {
                    const int ri = ks_ >> 1, T0 = (ks_ & 1) * 32;
                    bf16x8 af[4];
#pragma unroll
                    for (int ob = 0; ob < 4; ++ob) af[ob] = *(const LAS bf16x8*)(M2p + (ob * 16 + fr) * 272 + (ks_ * 32 + fq * 8) * 2);
#pragma unroll
                    for (int nb = 0; nb < 4; ++nb) {
                        const int cb = (ri * 512 + 64 * wave + nb * 16 + 4 * pp) * 2;
                        const s16x4 lo = __builtin_amdgcn_ds_read_tr16_b64_v4i16((LAS s16x4*)(tile + (T0 + 4 * fq + qq) * 2080 + cb));
                        const s16x4 hi = __builtin_amdgcn_ds_read_tr16_b64_v4i16((LAS s16x4*)(tile + (T0 + 16 + 4 * fq + qq) * 2080 + cb));
                        const bf16x8 bf = (bf16x8){lo.x, lo.y, lo.z, lo.w, hi.x, hi.y, hi.z, hi.w};
#pragma unroll
                        for (int ob = 0; ob < 4; ++ob) acc[ob][nb] = __builtin_amdgcn_mfma_f32_16x16x32_bf16(af[ob], bf, acc[ob][nb], 0, 0, 0);
                    }
                }
#pragma unroll
                for (int ob = 0; ob < 4; ++ob)
#pragma unroll
                    for (int e = 0; e < 4; ++e) {
                        float s = 0.f;
#pragma unroll
                        for (int nb = 0; nb < 4; ++nb) s += acc[ob][nb][e] * acc[ob][nb][e];
                        s += __shfl_xor(s, 1); s += __shfl_xor(s, 2); s += __shfl_xor(s, 4); s += __shfl_xor(s, 8);
                        if (fr == 0) red[(ob * 16 + 4 * fq + e) * 8 + wave] = s;
                    }
                __syncthreads();
                float gmv[4];
#pragma unroll
                for (int nb = 0; nb < 4; ++nb) gmv[nb] = gmix[1536 + 64 * wave + nb * 16 + fr];
#pragma unroll
                for (int ob = 0; ob < 4; ++ob)
#pragma unroll
                    for (int e = 0; e < 4; ++e) {
                        const int k2 = ob * 16 + 4 * fq + e;
                        const LAS f32x4* rp = (const LAS f32x4*)(red + k2 * 8); const f32x4 ra = rp[0], rb = rp[1];
                        const float tot = ((ra.x + ra.y) + (ra.z + ra.w)) + ((rb.x + rb.y) + (rb.z + rb.w));
                        const float rstd = 1.f / sqrtf(tot * (1.f / 512.f) + RMS_EPS);
                        bf16_t* orow = MIX + (size_t)(b * SEQ + k1 + 64 * k2) * D + 1536 + 64 * wave + fr;
#pragma unroll
                        for (int nb = 0; nb < 4; ++nb) orow[nb * 16] = f2bf(acc[ob][nb][e] * rstd * gmv[nb]);
                    }
                __syncthreads();
            }
        }
        grid.sync();
        if (PH(4)) {
            pg8::Gemm g{MIX, (const bf16_t*)(ws + WS_WO) + (size_t)l * D * D, M, D, D, D}; pg8::StaticOrder S; S.init(M, D, G, bid);
            pg8::EpiBf16 E{Y1, D};
            pg8::gemm_phase<pg8::EpiBf16, true>(lds, g, S, E);
        }
        grid.sync();
        if (PH(5)) { const int lane = launder(tid0) & 63; for (int m = gw; m < M; m += NGW) ln_row<true>(X + (size_t)m * D, Y1 + (size_t)m * D, args.in[10] + (size_t)l * D, args.in[11] + (size_t)l * D, X + (size_t)m * D, XB + (size_t)m * D, lane); }
        grid.sync();
        if (PH(6)) {
            pg8::Gemm g{XB, (const bf16_t*)(ws + WS_WGU) + (size_t)l * NGU * D, M, NGU, D, D}; pg8::StaticOrder S; S.init(M, NGU, G, bid);
            pg8::EpiBf16 E{GU, NGU};
            pg8::gemm_phase<pg8::EpiBf16, true>(lds, g, S, E);
        }
        grid.sync();
        if (PH(7)) {
            const int tid = launder(tid0);
            const float* cw = args.in[14] + (size_t)l * 3 * DFF; const float* cb = args.in[15] + (size_t)l * DFF;
            constexpr int NCH = DFF / 8, NRUN = M / 16;
            for (int idx = bid * 512 + tid; idx < NCH * NRUN; idx += G * 512) {
                const int ch = idx % NCH, run = idx / NCH, r0 = run * 16, t0 = r0 & (SEQ - 1), c0 = ch * 8;
                float w0[8], w1[8], w2[8], bb[8];
#pragma unroll
                for (int j = 0; j < 8; ++j) { w0[j] = cw[c0 + j]; w1[j] = cw[DFF + c0 + j]; w2[j] = cw[2 * DFF + c0 + j]; bb[j] = cb[c0 + j]; }
                float gp[8], gc[8], gn[8];
                if (t0 > 0) unpack8(*(const u32x4*)(GU + (size_t)(r0 - 1) * NGU + c0), gp); else {
#pragma unroll
                    for (int j = 0; j < 8; ++j) gp[j] = 0.f; }
                unpack8(*(const u32x4*)(GU + (size_t)r0 * NGU + c0), gc);
                for (int i = 0; i < 16; ++i) {
                    const int r = r0 + i;
                    if (t0 + i < SEQ - 1) unpack8(*(const u32x4*)(GU + (size_t)(r + 1) * NGU + c0), gn); else {
#pragma unroll
                        for (int j = 0; j < 8; ++j) gn[j] = 0.f; }
                    float uu[8]; unpack8(*(const u32x4*)(GU + (size_t)r * NGU + DFF + c0), uu);
                    float o[8];
#pragma unroll
                    for (int j = 0; j < 8; ++j) { const float y = w0[j] * gp[j] + w1[j] * gc[j] + w2[j] * gn[j] + bb[j]; o[j] = 0.5f * y * (1.f + erff(y * 0.70710678118654752f)) * uu[j]; }
                    u32x4 w; w.x = cvt_pk_bf16(o[0], o[1]); w.y = cvt_pk_bf16(o[2], o[3]); w.z = cvt_pk_bf16(o[4], o[5]); w.w = cvt_pk_bf16(o[6], o[7]);
                    *(u32x4*)(GU + (size_t)r * NGU + DFF + c0) = w;
#pragma unroll
                    for (int j = 0; j < 8; ++j) { gp[j] = gc[j]; gc[j] = gn[j]; }
                }
            }
        }
        grid.sync();
        if (PH(8)) {
            pg8::Gemm g{GU + DFF, (const bf16_t*)(ws + WS_WD) + (size_t)l * D * DFF, M, D, DFF, NGU}; pg8::StaticOrder S; S.init(M, D, G, bid);
            pg8::EpiBf16 E{XB, D};
            pg8::gemm_phase<pg8::EpiBf16, true>(lds, g, S, E);
        }
        grid.sync();
        if (PH(9)) { const int lane = launder(tid0) & 63; for (int m = gw; m < M; m += NGW) ln_row<true>(X + (size_t)m * D, XB + (size_t)m * D, args.in[17] + (size_t)l * D, args.in[18] + (size_t)l * D, X + (size_t)m * D, XB + (size_t)m * D, lane); }
        grid.sync();
    }
}

extern "C" void kernel_launch(void* const* d_in, const int* in_sizes, int n_in, void* d_out, int out_size, void* d_ws, size_t ws_size, hipStream_t stream) {
    static int grid_blocks = 0;
    if (grid_blocks == 0) {
        if (n_in != 19 || out_size != M * D || ws_size < WS_END) { fprintf(stderr, "kernel_launch: unexpected shapes (n_in %d, out %d, ws %zu, need %zu)\n", n_in, out_size, ws_size, (size_t)WS_END); grid_blocks = -1; return; }
        int dev = 0, cus = 0, per_cu = 0;
        (void)hipGetDevice(&dev);
        (void)hipDeviceGetAttribute(&cus, hipDeviceAttributeMultiprocessorCount, dev);
        if (hipFuncSetAttribute((const void*)fwd_kernel, hipFuncAttributeMaxDynamicSharedMemorySize, LDS_BYTES) != hipSuccess) { fprintf(stderr, "kernel_launch: hipFuncSetAttribute failed\n"); grid_blocks = -1; return; }
        if (hipOccupancyMaxActiveBlocksPerMultiprocessor(&per_cu, (const void*)fwd_kernel, 512, LDS_BYTES) != hipSuccess || per_cu < 1) { fprintf(stderr, "kernel_launch: occupancy query failed (%d)\n", per_cu); (void)hipGetLastError(); per_cu = 1; }
        grid_blocks = cus * per_cu;
        if (grid_blocks > 256) grid_blocks = 256;
    }
    if (grid_blocks < 0) return;
    Args a{};
    for (int i = 0; i < 19; ++i) a.in[i] = (const float*)d_in[i];
    a.out = (float*)d_out; a.ws = (unsigned char*)d_ws;
    void* kargs[] = {&a};
    hipError_t e = hipLaunchCooperativeKernel((const void*)fwd_kernel, dim3(grid_blocks), dim3(512), kargs, LDS_BYTES, stream);
    if (e != hipSuccess) fprintf(stderr, "cooperative launch failed: %s (grid %d)\n", hipGetErrorString(e), grid_blocks);
}
```

```cpp
#include <hip/hip_runtime.h>
#include <hip/hip_cooperative_groups.h>
#include <cstdio>
#include <cstdint>
namespace cg = cooperative_groups;

#define LAS __attribute__((address_space(3)))
typedef unsigned short bf16_t;
typedef short bf16x8 __attribute__((ext_vector_type(8)));
typedef short s16x4 __attribute__((ext_vector_type(4)));
typedef float f32x4 __attribute__((ext_vector_type(4)));
typedef float f32x2 __attribute__((ext_vector_type(2)));
typedef unsigned u32x4 __attribute__((ext_vector_type(4)));
typedef unsigned u32x2 __attribute__((ext_vector_type(2)));

constexpr int D = 2048, BATCH = 8, SEQ = 4096, DEPTH = 2, M = BATCH * SEQ;
constexpr int NZ = 4608;
constexpr int ZC_GB = 0, ZC_GC = 1024, ZC_V = 2048, ZC_POOL = 3072, ZC_FR = 3584, ZC_FI = 4096;
constexpr int DFF = 5632, NGU = 2 * DFF;
constexpr float ALPHA = 1.4142135623730951f;
constexpr float LN_EPS = 1e-5f, RMS_EPS = 1e-6f;

constexpr size_t MiB = 1u << 20;
constexpr size_t WS_WIN = 0;
constexpr size_t WS_WO = 36 * MiB;
constexpr size_t WS_WGU = 52 * MiB;
constexpr size_t WS_WD = 140 * MiB;
constexpr size_t WS_PW = 184 * MiB;
constexpr size_t WS_XB = 185 * MiB;
constexpr size_t WS_BIG = 313 * MiB;
constexpr size_t WS_Z = WS_BIG;
constexpr size_t WS_MIX = WS_BIG + 288 * MiB;
constexpr size_t WS_YP = WS_BIG + 416 * MiB;
constexpr size_t WS_EDGE = WS_BIG + 480 * MiB;
constexpr size_t EDGE_ELEMS = (size_t)128 * 2 * 5632;
constexpr size_t WS_END = WS_EDGE + 18 * MiB;

#ifndef PHMASK
#define PHMASK 0xFFFF
#endif
#define PH(n) ((PHMASK >> (n)) & 1)
constexpr int LDS_BYTES = 155648;

__device__ __forceinline__ unsigned cvt_pk_bf16(float lo, float hi) { unsigned r; asm volatile("v_cvt_pk_bf16_f32 %0, %1, %2" : "=v"(r) : "v"(lo), "v"(hi)); return r; }
__device__ __forceinline__ bf16_t f2bf(float x) { return (bf16_t)(cvt_pk_bf16(x, 0.f) & 0xffffu); }
__device__ __forceinline__ float bf_lo(unsigned w) { return __uint_as_float(w << 16); }
__device__ __forceinline__ float bf_hi(unsigned w) { return __uint_as_float(w & 0xffff0000u); }
__device__ __forceinline__ float bf2f(bf16_t b) { return __uint_as_float(((unsigned)b) << 16); }
__device__ __forceinline__ void unpack8(const u32x4 w, float (&f)[8]) {
    f[0] = bf_lo(w.x); f[1] = bf_hi(w.x); f[2] = bf_lo(w.y); f[3] = bf_hi(w.y); f[4] = bf_lo(w.z); f[5] = bf_hi(w.z); f[6] = bf_lo(w.w); f[7] = bf_hi(w.w);
}
__device__ __forceinline__ int launder(int x) { asm volatile("" : "+v"(x)); return x; }
__device__ __forceinline__ float wave_sum(float v) {
#pragma unroll
    for (int o = 1; o < 64; o <<= 1) v += __shfl_xor(v, o);
    return v;
}

namespace pg8 {
constexpr int BM = 256, BK = 64, HALF = 128, HTB = HALF * BK * 2, STAGE_BYTES = 8 * HTB, NXCD = 8, WGM = 8;
__host__ __device__ __forceinline__ int lds_byte(int r, int c) { const int st = (r >> 4) * 2 + (c >> 5), rr = r & 15, cc = c & 31, ob = rr * 64 + cc * 2; return st * 1024 + (ob ^ (((ob >> 9) & 1) << 5)); }
__host__ __device__ __forceinline__ void stage_rc(int b, int& R, int& C) { const int st = b / 1024, sb = b % 1024, swz = sb ^ (((sb >> 9) & 1) << 5); R = (st >> 1) * 16 + swz / 64; C = (st & 1) * 32 + (swz % 64) / 2; }
__host__ __device__ __forceinline__ int perm32(int rho) { const int n = rho >> 4, i = rho & 15; return 8 * (i >> 2) + 4 * n + (i & 3); }

struct Unit { int pm, pn; };
struct Gemm { const bf16_t* A; const bf16_t* Bt; int M, N, K, lda; };

struct StaticOrder {
    int nM, nN, nwg, G, c;
    __device__ void init(int M_, int N_, int G_, int c_) { nM = M_ / BM; nN = N_ / BM; nwg = nM * nN; G = G_; c = c_; }
    __device__ bool next(int i, Unit& u) const {
        const long L = (long)i * G + c; if (L >= nwg) return false;
        int wgid = (int)L; { const int q = nwg / NXCD, r = nwg % NXCD, xcd = wgid % NXCD, off = wgid / NXCD; wgid = (xcd < r ? xcd * (q + 1) : r * (q + 1) + (xcd - r) * q) + off; }
        const int nig = WGM * nN, gid = wgid / nig, fm = gid * WGM, gsz = (nM - fm) < WGM ? (nM - fm) : WGM;
        u.pm = fm + ((wgid % nig) % gsz); u.pn = (wgid % nig) / gsz; return true;
    }
};

struct EpiBf16 {
    static constexpr bool PERM = true;
    bf16_t* O; int ldc;
    __device__ __forceinline__ void operator()(const f32x4 (&acc)[2][2][4][2], const Unit& u, int wr, int wc, int fr, int fq) const {
        const int row0 = u.pm * BM + wr * 64 + fr; const int col0 = u.pn * BM + wc * 32 + 8 * fq;
#pragma unroll
        for (int ai = 0; ai < 2; ++ai)
#pragma unroll
            for (int m = 0; m < 4; ++m) { bf16_t* rowp = O + (size_t)(row0 + ai * HALF + m * 16) * ldc + col0;
#pragma unroll
                for (int bj = 0; bj < 2; ++bj) { const f32x4 v0 = acc[ai][bj][m][0], v1 = acc[ai][bj][m][1];
                    u32x4 w; w.x = cvt_pk_bf16(v0[0], v0[1]); w.y = cvt_pk_bf16(v0[2], v0[3]); w.z = cvt_pk_bf16(v1[0], v1[1]); w.w = cvt_pk_bf16(v1[2], v1[3]);
                    *(u32x4*)(rowp + bj * HALF) = w; } }
    }
};
struct EpiRes {
    static constexpr bool PERM = false;
    float* X; int ldc; float alpha;
    __device__ __forceinline__ void operator()(const f32x4 (&acc)[2][2][4][2], const Unit& u, int wr, int wc, int fr, int fq) const {
        const int row0 = u.pm * BM + wr * 64 + fr, col0 = u.pn * BM + wc * 32 + 4 * fq;
#pragma unroll
        for (int ai = 0; ai < 2; ++ai)
#pragma unroll
            for (int m = 0; m < 4; ++m) { float* rowp = X + (size_t)(row0 + ai * HALF + m * 16) * ldc + col0;
#pragma unroll
                for (int bj = 0; bj < 2; ++bj)
#pragma unroll
                    for (int n = 0; n < 2; ++n) { f32x4* p = (f32x4*)(rowp + bj * HALF + n * 16); const f32x4 xv = *p; *p = xv * alpha + acc[ai][bj][m][n]; }
                asm volatile("" ::: "memory"); }
    }
};

__device__ __forceinline__ f32x2 gelu_pk(f32x2 v) {
    const f32x2 av = __builtin_elementwise_abs(v), d = av * 0.2316418882f + 1.0f;
    f32x2 t; t.x = __builtin_amdgcn_rcpf(d.x); t.y = __builtin_amdgcn_rcpf(d.y);
    f32x2 q = t * 0.5307027145f + (-0.7265760135f); q = q * t + 0.7107068705f; q = q * t + (-0.142248368f); q = q * t + 0.127414796f; q = q * t;
    const f32x2 s = (v * v) * (-0.72134752044f);
    f32x2 e; e.x = __builtin_amdgcn_exp2f(s.x); e.y = __builtin_amdgcn_exp2f(s.y);
    const f32x2 m = v * (q * e), r = v - m;
    f32x2 o; o.x = v.x < 0.f ? m.x : r.x; o.y = v.y < 0.f ? m.y : r.y; return o;
}
__device__ __forceinline__ f32x4 gelu4(f32x4 v) { const f32x2 a = gelu_pk((f32x2){v.x, v.y}), b = gelu_pk((f32x2){v.z, v.w}); return (f32x4){a.x, a.y, b.x, b.y}; }
__device__ __forceinline__ float dpp_ror1(float x) { return __builtin_bit_cast(float, __builtin_amdgcn_update_dpp(0, __builtin_bit_cast(int, x), 0x121, 0xf, 0xf, false)); }
__device__ __forceinline__ float dpp_rol1(float x) { return __builtin_bit_cast(float, __builtin_amdgcn_update_dpp(0, __builtin_bit_cast(int, x), 0x12F, 0xf, 0xf, false)); }
__device__ __forceinline__ f32x4 ror4(f32x4 v) { return (f32x4){dpp_ror1(v.x), dpp_ror1(v.y), dpp_ror1(v.z), dpp_ror1(v.w)}; }
__device__ __forceinline__ f32x4 rol4(f32x4 v) { return (f32x4){dpp_rol1(v.x), dpp_rol1(v.y), dpp_rol1(v.z), dpp_rol1(v.w)}; }
__device__ __forceinline__ f32x4 sel4(bool c, f32x4 a, f32x4 b) { return (f32x4){c ? a.x : b.x, c ? a.y : b.y, c ? a.z : b.z, c ? a.w : b.w}; }

struct EpiGU {
    static constexpr bool PERM = true;
    bf16_t* H; int ldh; const float* cw; const float* cb; int dff; float* EG; float* EP; float* EU; LAS float* halo;
    __device__ __forceinline__ void operator()(const f32x4 (&acc)[2][2][4][2], const Unit& u, int wr, int wc, int fr, int fq) const {
        const int fl = wc * 32 + 8 * fq, f0 = u.pn * HALF + fl;
#pragma unroll
        for (int ai = 0; ai < 2; ++ai) { LAS float* hp = halo + ((ai * 2 + wr) * 2) * 128 + fl;
            if (fr == 0) { *(LAS f32x4*)(hp) = acc[ai][0][0][0]; *(LAS f32x4*)(hp + 4) = acc[ai][0][0][1]; }
            if (fr == 15) { *(LAS f32x4*)(hp + 128) = acc[ai][0][3][0]; *(LAS f32x4*)(hp + 132) = acc[ai][0][3][1]; } }
        asm volatile("s_waitcnt lgkmcnt(0)" ::: "memory"); __builtin_amdgcn_s_barrier(); asm volatile("" ::: "memory");
        const f32x4 zero4 = (f32x4){0.f, 0.f, 0.f, 0.f};
#pragma unroll
        for (int n = 0; n < 2; ++n) {
            const f32x4 w0 = *(const f32x4*)(cw + f0 + 4 * n), w1 = *(const f32x4*)(cw + dff + f0 + 4 * n), w2 = *(const f32x4*)(cw + 2 * dff + f0 + 4 * n), bb = *(const f32x4*)(cb + f0 + 4 * n);
#pragma unroll
            for (int ai = 0; ai < 2; ++ai) {
                const int idx = ai * 2 + wr;
                const f32x4 hprev = (idx > 0) ? *(const LAS f32x4*)(halo + ((idx - 1) * 2 + 1) * 128 + fl + 4 * n) : zero4;
                const f32x4 hnext = (idx < 3) ? *(const LAS f32x4*)(halo + ((idx + 1) * 2) * 128 + fl + 4 * n) : zero4;
                f32x4 rr[4], rl[4];
#pragma unroll
                for (int m = 0; m < 4; ++m) { rr[m] = ror4(acc[ai][0][m][n]); rl[m] = rol4(acc[ai][0][m][n]); }
#pragma unroll
                for (int m = 0; m < 4; ++m) {
                    const f32x4 pv = sel4(fr == 0, m > 0 ? rr[m > 0 ? m - 1 : 0] : hprev, rr[m]);
                    const f32x4 nx = sel4(fr == 15, m < 3 ? rl[m < 3 ? m + 1 : 3] : hnext, rl[m]);
                    const f32x4 y = w0 * pv + w1 * acc[ai][0][m][n] + w2 * nx + bb;
                    if (ai == 0 && m == 0) { if (wr == 0 && fr == 0) { const size_t eo = ((size_t)u.pm * 2 + 0) * dff + f0 + 4 * n; *(f32x4*)(EG + eo) = acc[0][0][0][n]; *(f32x4*)(EP + eo) = y; *(f32x4*)(EU + eo) = acc[0][1][0][n]; } }
                    if (ai == 1 && m == 3) { if (wr == 1 && fr == 15) { const size_t eo = ((size_t)u.pm * 2 + 1) * dff + f0 + 4 * n; *(f32x4*)(EG + eo) = acc[1][0][3][n]; *(f32x4*)(EP + eo) = y; *(f32x4*)(EU + eo) = acc[1][1][3][n]; } }
                    const f32x4 o = gelu4(y) * acc[ai][1][m][n];
                    u32x2 w; w.x = cvt_pk_bf16(o.x, o.y); w.y = cvt_pk_bf16(o.z, o.w);
                    *(u32x2*)(H + (size_t)(u.pm * BM + ai * HALF + wr * 64 + m * 16 + fr) * ldh + f0 + 4 * n) = w;
                }
            }
        }
    }
};

template <class Epi, bool ALIGN_EPI>
__device__ __forceinline__ void gemm_phase(LAS unsigned char* lds, const Gemm g, const StaticOrder& S, const Epi& E) {
    const int tid = launder(threadIdx.x), wid = __builtin_amdgcn_readfirstlane(tid >> 6), lane = tid & 63, wr = wid >> 2, wc = wid & 3, fr = lane & 15, fq = lane >> 4;
    const int K = g.K, nt = K / BK, lda = g.lda;
    unsigned voffA[2], voffB[2];
#pragma unroll
    for (int i = 0; i < 2; ++i) { int R, C; stage_rc(tid * 16 + i * 8192, R, C); const int Rb = Epi::PERM ? ((R & ~31) + perm32(R & 31)) : R;
        voffA[i] = (unsigned)(R * lda + C) * 2u; voffB[i] = (unsigned)(Rb * K + C) * 2u; }
    const size_t kstep = (size_t)(BK * 2);
    const size_t hstepA = (size_t)HALF * lda * 2, hstepB = (size_t)HALF * K * 2;
    const size_t tstepA = 2 * hstepA, tstepB = 2 * hstepB;
    const unsigned ldsw = (unsigned)wid * 1024u;
    const int aoff = lds_byte(wr * 64 + fr, fq * 8), boff = lds_byte(wc * 32 + fr, fq * 8);
#define PG8_SA(b, h) (((b) * 2 + (h)) * HTB)
#define PG8_SB(b, h) ((4 + (b) * 2 + (h)) * HTB)
#define PG8_STAGE(bufoff, gbase, voff) do { _Pragma("unroll") for (int _i = 0; _i < 2; ++_i) \
        __builtin_amdgcn_global_load_lds((const unsigned*)((const char*)(gbase) + (voff)[_i]), (LAS unsigned*)(lds + (bufoff) + ldsw + _i * 8192), 16, 0, 0); } while (0)
#define PG8_LDA(dst, b, h) do { _Pragma("unroll") for (int m = 0; m < 4; ++m) _Pragma("unroll") for (int k = 0; k < 2; ++k) dst[m][k] = *(const LAS bf16x8*)(lds + PG8_SA(b, h) + aoff + m * 2048 + k * 1024); } while (0)
#define PG8_LDB(dst, b, h) do { _Pragma("unroll") for (int n = 0; n < 2; ++n) _Pragma("unroll") for (int k = 0; k < 2; ++k) dst[n][k] = *(const LAS bf16x8*)(lds + PG8_SB(b, h) + boff + n * 2048 + k * 1024); } while (0)
#define PG8_MMA(ai, bj, At, Bt) do { __builtin_amdgcn_s_setprio(1); _Pragma("unroll") for (int m = 0; m < 4; ++m) _Pragma("unroll") for (int n = 0; n < 2; ++n) _Pragma("unroll") for (int k = 0; k < 2; ++k) \
        acc[ai][bj][m][n] = __builtin_amdgcn_mfma_f32_16x16x32_bf16(Bt[n][k], At[m][k], acc[ai][bj][m][n], 0, 0, 0); __builtin_amdgcn_s_setprio(0); } while (0)
#define PG8_WAIT_V(n) asm volatile("s_waitcnt vmcnt(" #n ")" ::: "memory")
#define PG8_WAIT_L(n) asm volatile("s_waitcnt lgkmcnt(" #n ")" ::: "memory")
#define PG8_BAR __builtin_amdgcn_s_barrier()
#define PG8_SCHED __builtin_amdgcn_sched_barrier(0)
    Unit cur, nxt; int ui = 0;
    if (!S.next(0, cur)) return;
    f32x4 acc[2][2][4][2];
#pragma unroll
    for (int a = 0; a < 2; ++a)
#pragma unroll
        for (int b = 0; b < 2; ++b)
#pragma unroll
            for (int m = 0; m < 4; ++m)
#pragma unroll
                for (int n = 0; n < 2; ++n) acc[a][b][m][n] = (f32x4){0.f, 0.f, 0.f, 0.f};
    bf16x8 At[4][2], B0[2][2], B1[2][2];
    const char* cA = (const char*)g.A + (size_t)cur.pm * tstepA; const char* cB = (const char*)g.Bt + (size_t)cur.pn * tstepB;
    PG8_STAGE(PG8_SB(0, 0), cB, voffB); PG8_STAGE(PG8_SB(0, 1), cB + hstepB, voffB); PG8_STAGE(PG8_SA(0, 0), cA, voffA); PG8_STAGE(PG8_SA(0, 1), cA + hstepA, voffA);
    if (wr == 1) PG8_BAR;
    PG8_WAIT_V(2); PG8_BAR;
    PG8_STAGE(PG8_SB(1, 0), cB + kstep, voffB); PG8_STAGE(PG8_SA(1, 0), cA + kstep, voffA); PG8_STAGE(PG8_SB(1, 1), cB + hstepB + kstep, voffB);
    PG8_WAIT_V(6); PG8_BAR;
    for (;;) {
        const bool has_next = S.next(ui + 1, nxt);
        const char* nA = has_next ? (const char*)g.A + (size_t)nxt.pm * tstepA : cA; const char* nB = has_next ? (const char*)g.Bt + (size_t)nxt.pn * tstepB : cB;
        for (int t = 0; t < nt; t += 2) {
            const bool last = (t == nt - 2);
            const char* a1 = cA + (size_t)(t + 1) * kstep;
            const char* a2 = last ? nA : cA + (size_t)(t + 2) * kstep; const char* b2 = last ? nB : cB + (size_t)(t + 2) * kstep;
            const char* a3 = a2 + kstep; const char* b3 = b2 + kstep;
            PG8_LDB(B0, 0, 0); PG8_LDB(B1, 0, 1); PG8_SCHED; PG8_LDA(At, 0, 0); PG8_STAGE(PG8_SA(1, 1), a1 + hstepA, voffA);
            PG8_WAIT_V(8); PG8_WAIT_L(0); PG8_BAR; PG8_MMA(0, 0, At, B0); PG8_MMA(0, 1, At, B1); PG8_BAR; PG8_SCHED;
            PG8_LDA(At, 0, 1); PG8_STAGE(PG8_SB(0, 0), b2, voffB); PG8_STAGE(PG8_SB(0, 1), b2 + hstepB, voffB); PG8_STAGE(PG8_SA(0, 0), a2, voffA);
            PG8_WAIT_V(8); PG8_WAIT_L(0); PG8_BAR; PG8_MMA(1, 0, At, B0); PG8_MMA(1, 1, At, B1); PG8_BAR; PG8_SCHED;
            PG8_LDB(B0, 1, 0); PG8_LDB(B1, 1, 1); PG8_SCHED; PG8_LDA(At, 1, 0); PG8_STAGE(PG8_SA(0, 1), a2 + hstepA, voffA);
            PG8_WAIT_V(8); PG8_WAIT_L(0); PG8_BAR; PG8_MMA(0, 0, At, B0); PG8_MMA(0, 1, At, B1); PG8_BAR; PG8_SCHED;
            PG8_LDA(At, 1, 1); PG8_STAGE(PG8_SB(1, 0), b3, voffB); PG8_STAGE(PG8_SB(1, 1), b3 + hstepB, voffB); PG8_STAGE(PG8_SA(1, 0), a3, voffA);
            PG8_WAIT_V(8); PG8_WAIT_L(0); PG8_BAR; PG8_MMA(1, 0, At, B0); PG8_MMA(1, 1, At, B1); PG8_BAR; PG8_SCHED;
        }
        if constexpr (ALIGN_EPI) { if (wr == 0) PG8_BAR; }
        E(acc, cur, wr, wc, fr, fq);
        if (!has_next) break;
#pragma unroll
        for (int a = 0; a < 2; ++a)
#pragma unroll
            for (int b = 0; b < 2; ++b)
#pragma unroll
                for (int m = 0; m < 4; ++m)
#pragma unroll
                    for (int n = 0; n < 2; ++n) acc[a][b][m][n] = (f32x4){0.f, 0.f, 0.f, 0.f};
        cur = nxt; cA = nA; cB = nB; ++ui;
        if constexpr (ALIGN_EPI) { if (wr == 1) PG8_BAR; }
    }
    PG8_WAIT_V(0);
    if constexpr (!ALIGN_EPI) { if (wr == 0) PG8_BAR; }
    PG8_BAR;
#undef PG8_SA
#undef PG8_SB
#undef PG8_STAGE
#undef PG8_LDA
#undef PG8_LDB
#undef PG8_MMA
#undef PG8_WAIT_V
#undef PG8_WAIT_L
#undef PG8_BAR
#undef PG8_SCHED
}
}

struct Args { const float* in[19]; float* out; unsigned char* ws; };

#define LDS_WAIT() asm volatile("s_waitcnt lgkmcnt(0)" ::: "memory")

__device__ __forceinline__ void p0_transpose_item(const float* W, int K, int pitch, int nblk, bf16_t* WT, int row_off, LAS float* scr, int item, int lane, int il = 0) {
    const int kb = item / nblk, nb = item % nblk, k0 = 64 * kb, n0 = 32 * nb;
    const int rbase = il ? ((n0 >> 7) * 256 + (n0 & 127) + (il == 2 ? 128 : 0)) : row_off + n0;
#pragma unroll 8
    for (int i = 0; i < 32; ++i) { const int kk = 2 * i + (lane >> 5); scr[kk * 33 + (lane & 31)] = W[(size_t)(k0 + kk) * pitch + n0 + (lane & 31)]; }
    LDS_WAIT(); asm volatile("" ::: "memory");
    const int c = lane & 7;
#pragma unroll
    for (int j = 0; j < 4; ++j) { const int n = (lane >> 3) + 8 * j; const LAS float* s = scr + (8 * c) * 33 + n;
        u32x4 o; o.x = cvt_pk_bf16(s[0 * 33], s[1 * 33]); o.y = cvt_pk_bf16(s[2 * 33], s[3 * 33]); o.z = cvt_pk_bf16(s[4 * 33], s[5 * 33]); o.w = cvt_pk_bf16(s[6 * 33], s[7 * 33]);
        *(u32x4*)(WT + (size_t)(rbase + n) * K + k0 + 8 * c) = o; }
    LDS_WAIT(); asm volatile("" ::: "memory");
}

template <bool ADD>
__device__ __forceinline__ void ln_row(const float* xrow, const bf16_t* yrow, const float* g, const float* b, float* orow, bf16_t* obrow, int lane) {
    const f32x4* xr = (const f32x4*)xrow + lane;
    f32x4 v[8]; float s = 0.f;
    if (ADD) {
        const u32x2* yr = (const u32x2*)yrow + lane; u32x2 yv[8];
#pragma unroll
        for (int j = 0; j < 8; ++j) { v[j] = xr[64 * j]; yv[j] = yr[64 * j]; }
#pragma unroll
        for (int j = 0; j < 8; ++j) { v[j] = v[j] * ALPHA + (f32x4){bf_lo(yv[j].x), bf_hi(yv[j].x), bf_lo(yv[j].y), bf_hi(yv[j].y)}; s += (v[j].x + v[j].y) + (v[j].z + v[j].w); }
    } else {
#pragma unroll
    for (int j = 0; j < 8; ++j) { v[j] = xr[64 * j]; s += (v[j].x + v[j].y) + (v[j].z + v[j].w); }
    }
    const float mean = wave_sum(s) * (1.f / D); float s2 = 0.f;
#pragma unroll
    for (int j = 0; j < 8; ++j) { v[j] = v[j] - mean; s2 += (v[j].x * v[j].x + v[j].y * v[j].y) + (v[j].z * v[j].z + v[j].w * v[j].w); }
    const float rstd = 1.f / sqrtf(wave_sum(s2) * (1.f / D) + LN_EPS);
    const f32x4* gp = (const f32x4*)g + lane; const f32x4* bp = (const f32x4*)b + lane;
    f32x4* op = (f32x4*)orow + lane; u32x2* ob = (u32x2*)obrow + lane;
#pragma unroll
    for (int j = 0; j < 8; ++j) { const f32x4 o = v[j] * rstd * gp[64 * j] + bp[64 * j]; op[64 * j] = o;
        u32x2 w; w.x = cvt_pk_bf16(o.x, o.y); w.y = cvt_pk_bf16(o.z, o.w); ob[64 * j] = w; }
}

__global__ void __launch_bounds__(512, 2) fwd_kernel(Args args) {
    extern __shared__ __attribute__((aligned(16))) unsigned char lds_raw[];
    LAS unsigned char* lds = (LAS unsigned char*)lds_raw;
    cg::grid_group grid = cg::this_grid();
    const int tid0 = threadIdx.x, wave = __builtin_amdgcn_readfirstlane(tid0 >> 6);
    const int G = gridDim.x, bid = blockIdx.x;
    const int gw = bid * 8 + wave, NGW = G * 8;
    unsigned char* ws = args.ws;
    float* X = args.out;
    bf16_t* XB = (bf16_t*)(ws + WS_XB);
    bf16_t* Z = (bf16_t*)(ws + WS_Z);
    bf16_t* MIX = (bf16_t*)(ws + WS_MIX);
    bf16_t* YP = (bf16_t*)(ws + WS_YP);
    bf16_t* HB = (bf16_t*)(ws + WS_BIG);
    float* EDG = (float*)(ws + WS_EDGE);
    bf16_t* PWT = (bf16_t*)(ws + WS_PW);
    bf16_t* Y1 = (bf16_t*)(ws + WS_Z);

    if (PH(0)) {
        const int tid = launder(tid0), lane = tid & 63;
        for (int it = bid; it < 256; it += G) {
            const int l = it >> 7, h = (it >> 5) & 3, cs = (it >> 4) & 1, kc = it & 15;
            LAS float* CW = (LAS float*)lds;
            {
                const int c = tid >> 2, d0 = (tid & 3) * 32;
                float a[32];
#pragma unroll
                for (int j = 0; j < 32; ++j) a[j] = 0.f;
                const float* Wf = args.in[7] + ((size_t)(l * 4 + h) * 128) * 128 + d0;
                for (int cp = 0; cp < 128; ++cp) {
                    const float fr_ = (float)((c * cp) & 127) * (1.f / 128.f);
                    const float tw = cs ? -__builtin_amdgcn_sinf(fr_) : __builtin_amdgcn_cosf(fr_);
                    const f32x4* wr_ = (const f32x4*)(Wf + (size_t)cp * 128);
#pragma unroll
                    for (int j = 0; j < 8; ++j) { const f32x4 w = wr_[j]; a[4 * j] += tw * w.x; a[4 * j + 1] += tw * w.y; a[4 * j + 2] += tw * w.z; a[4 * j + 3] += tw * w.w; }
                }
#pragma unroll
                for (int j = 0; j < 32; ++j) CW[c * 128 + d0 + j] = a[j] * 0.08838834764831845f;
            }
            __syncthreads();
            {
                const int k = kc * 128 + (tid & 127), d0 = (tid >> 7) * 32;
                float a[32];
#pragma unroll
                for (int j = 0; j < 32; ++j) a[j] = 0.f;
                const float* wrow = args.in[3] + ((size_t)l * D + k) * 4096 + 3584 + h * 128;
                for (int c4 = 0; c4 < 32; ++c4) {
                    const f32x4 wv = *(const f32x4*)(wrow + 4 * c4);
#pragma unroll
                    for (int cc = 0; cc < 4; ++cc) { const float av = wv[cc]; const LAS f32x4* cwp = (const LAS f32x4*)(CW + (4 * c4 + cc) * 128 + d0);
#pragma unroll
                        for (int j = 0; j < 8; ++j) { const f32x4 w = cwp[j]; a[4 * j] += av * w.x; a[4 * j + 1] += av * w.y; a[4 * j + 2] += av * w.z; a[4 * j + 3] += av * w.w; } }
                }
                bf16_t* dst = (bf16_t*)(ws + WS_WIN) + ((size_t)l * NZ + ZC_FR + cs * 512 + h * 128 + d0) * D + k;
#pragma unroll
                for (int j = 0; j < 32; ++j) dst[(size_t)j * D] = f2bf(a[j]);
            }
            __syncthreads();
        }
        {
            LAS float* scr = (LAS float*)(lds + wave * 16384);
            constexpr int I_IN = 32 * 112, I_O = 32 * 64, I_G = 32 * 176, I_D = 88 * 64, I_L = I_IN + I_O + 2 * I_G + I_D;
            for (int it = gw; it < 2 * I_L; it += NGW) {
                const int l = it / I_L; int r = it - l * I_L;
                if (r < I_IN) { p0_transpose_item(args.in[3] + (size_t)l * D * 4096, D, 4096, 112, (bf16_t*)(ws + WS_WIN) + (size_t)l * NZ * D, 0, scr, r, lane); continue; } r -= I_IN;
                if (r < I_O) { p0_transpose_item(args.in[9] + (size_t)l * D * D, D, D, 64, (bf16_t*)(ws + WS_WO) + (size_t)l * D * D, 0, scr, r, lane); continue; } r -= I_O;
                if (r < I_G) { p0_transpose_item(args.in[12] + (size_t)l * D * DFF, D, DFF, 176, (bf16_t*)(ws + WS_WGU) + (size_t)l * NGU * D, 0, scr, r, lane, 1); continue; } r -= I_G;
                if (r < I_G) { p0_transpose_item(args.in[13] + (size_t)l * D * DFF, D, DFF, 176, (bf16_t*)(ws + WS_WGU) + (size_t)l * NGU * D, DFF, scr, r, lane, 2); continue; } r -= I_G;
                p0_transpose_item(args.in[16] + (size_t)l * DFF * D, DFF, D, 64, (bf16_t*)(ws + WS_WD) + (size_t)l * D * DFF, 0, scr, r, lane);
            }
        }
        for (int i = bid * 512 + tid; i < 2 * 4 * 128 * 128; i += G * 512) { const int c = i & 127, d = (i >> 7) & 127, lg = i >> 14; PWT[i] = f2bf(args.in[5][((size_t)lg * 128 + c) * 128 + d]); }
        for (int m = gw; m < M; m += NGW) ln_row<false>(args.in[0] + (size_t)m * D, nullptr, args.in[1], args.in[2], X + (size_t)m * D, XB + (size_t)m * D, lane);
    }
    grid.sync();

    for (int l = 0; l < DEPTH; ++l) {
        if (PH(1)) {
            pg8::Gemm g{XB, (const bf16_t*)(ws + WS_WIN) + (size_t)l * NZ * D, M, NZ, D, D}; pg8::StaticOrder S; S.init(M, NZ, G, bid);
            pg8::EpiBf16 E{Z, NZ};
            pg8::gemm_phase<pg8::EpiBf16, true>(lds, g, S, E);
        }
        grid.sync();
        if (PH(2)) {
            const int tid = launder(tid0), lane = tid & 63;
            const float* gmix = args.in[8] + (size_t)l * D;
            LAS unsigned char* M1p = lds;
            LAS unsigned char* tile = lds + 128 * 272;
            for (int i = tid; i < 128 * 128; i += 512) {
                const int o = i >> 7, ks_ = (i >> 5) & 3, kq = (i >> 3) & 3, e = (i >> 2) & 1, q = i & 3;
                const int ro = o >> 6, k1 = o & 63, ri = ks_ >> 1, t1 = (ks_ & 1) * 32 + 16 * e + 4 * kq + q;
                const float fr_ = (float)((k1 * t1) & 63) * (1.f / 64.f);
                const float c = __builtin_amdgcn_cosf(fr_) * 0.125f, s = __builtin_amdgcn_sinf(fr_) * 0.125f;
                const float v = (ro == ri) ? c : (ro == 0 ? s : -s);
                *(LAS bf16_t*)(M1p + o * 272 + (i & 127) * 2) = f2bf(v);
            }
            __syncthreads();
            const int fr = lane & 15, fq = lane >> 4, qq = fr >> 2, pp = fr & 3;
            for (int it = bid; it < 1024; it += G) {
                const int b = it >> 7, t2 = (it >> 1) & 63, half = it & 1;
#pragma unroll
                for (int i = 0; i < 8; ++i) { const int idx = tid + 512 * i, row = idx >> 6, ch = idx & 63, ri = ch >> 5, cc = ch & 31;
                    const u32x4 v = *(const u32x4*)(Z + (size_t)(b * SEQ + 64 * row + t2) * NZ + ZC_FR + ri * 512 + half * 256 + cc * 8);
                    *(LAS u32x4*)(tile + row * 1056 + ri * 512 + cc * 16) = v; }
                __syncthreads();
                f32x4 acc[8][2];
#pragma unroll
                for (int a = 0; a < 8; ++a) { acc[a][0] = (f32x4){0.f, 0.f, 0.f, 0.f}; acc[a][1] = (f32x4){0.f, 0.f, 0.f, 0.f}; }
#pragma unroll
                for (int ks_ = 0; ks_ < 4; ++ks_) {
                    const int ri = ks_ >> 1, T0 = (ks_ & 1) * 32;
                    bf16x8 bfrag[2];
#pragma unroll
                    for (int nb = 0; nb < 2; ++nb) {
                        const int cb = (ri * 256 + 32 * wave + nb * 16 + 4 * pp) * 2;
                        const s16x4 lo = __builtin_amdgcn_ds_read_tr16_b64_v4i16((LAS s16x4*)(tile + (T0 + 4 * fq + qq) * 1056 + cb));
                        const s16x4 hi = __builtin_amdgcn_ds_read_tr16_b64_v4i16((LAS s16x4*)(tile + (T0 + 16 + 4 * fq + qq) * 1056 + cb));
                        bfrag[nb] = (bf16x8){lo.x, lo.y, lo.z, lo.w, hi.x, hi.y, hi.z, hi.w};
                    }
#pragma unroll
                    for (int ob = 0; ob < 8; ++ob) {
                        const bf16x8 af = *(const LAS bf16x8*)(M1p + (ob * 16 + fr) * 272 + (ks_ * 32 + fq * 8) * 2);
                        acc[ob][0] = __builtin_amdgcn_mfma_f32_16x16x32_bf16(af, bfrag[0], acc[ob][0], 0, 0, 0);
                        acc[ob][1] = __builtin_amdgcn_mfma_f32_16x16x32_bf16(af, bfrag[1], acc[ob][1], 0, 0, 0);
                    }
                }
#pragma unroll
                for (int ob = 0; ob < 4; ++ob)
#pragma unroll
                    for (int e = 0; e < 4; ++e) {
                        const int k1 = ob * 16 + 4 * fq + e;
                        const float fr_ = (float)(k1 * t2) * (1.f / 4096.f);
                        const float ct = __builtin_amdgcn_cosf(fr_), st = __builtin_amdgcn_sinf(fr_);
                        bf16_t* dst = YP + ((size_t)((b * 64 + k1) * 64 + t2)) * 1024 + half * 256 + 32 * wave + fr;
#pragma unroll
                        for (int nb = 0; nb < 2; ++nb) {
                            const float yr = acc[ob][nb][e], yi = acc[ob + 4][nb][e];
                            dst[nb * 16] = f2bf(yr * ct + yi * st);
                            dst[512 + nb * 16] = f2bf(yi * ct - yr * st);
                        }
                    }
                __syncthreads();
            }
            {
                LAS unsigned char* Ht = lds;
                LAS unsigned char* Pt = lds + 48 * 1040;
                LAS float* red = (LAS float*)(lds + 48 * 1040 + 32 * 1040);
                const bf16_t* pw = PWT + (size_t)l * 4 * 128 * 128;
                const float* pscale = args.in[6] + (size_t)l * 512;
                const int g_ = wave >> 1, dh = wave & 1;
                for (int it = bid; it < M / 32; it += G) {
                    const int r0 = it * 32, t0 = r0 & (SEQ - 1);
#pragma unroll
                    for (int i = 0; i < 6; ++i) { const int idx = tid + 512 * i, row = idx >> 6, ch = idx & 63; const int t = t0 - 8 + row;
                        u32x4 v = (u32x4){0u, 0u, 0u, 0u};
                        if (t >= 0 && t < SEQ) v = *(const u32x4*)(Z + (size_t)(r0 - 8 + row) * NZ + ZC_POOL + ch * 8);
                        *(LAS u32x4*)(Ht + row * 1040 + ch * 16) = v; }
                    __syncthreads();
                    {
                        const int c = tid, gi = c >> 7, hf = 1 << gi;
                        float s = 0.f;
                        for (int j = -hf; j < hf; ++j) s += bf2f(*(const LAS bf16_t*)(Ht + (8 + j) * 1040 + c * 2));
                        for (int tt = 0; tt < 32; ++tt) {
                            const int t = t0 + tt;
                            const int hi_ = (t + hf < SEQ) ? t + hf : SEQ, lo_ = (t - hf > 0) ? t - hf : 0;
                            const float cnt = (float)(hi_ - lo_);
                            const float hc = bf2f(*(const LAS bf16_t*)(Ht + (8 + tt) * 1040 + c * 2));
                            *(LAS bf16_t*)(Pt + tt * 1040 + c * 2) = f2bf(s / cnt - hc);
                            s += bf2f(*(const LAS bf16_t*)(Ht + (8 + tt + hf) * 1040 + c * 2)) - bf2f(*(const LAS bf16_t*)(Ht + (8 + tt - hf) * 1040 + c * 2));
                        }
                    }
                    __syncthreads();
                    f32x4 acc[2][4];
#pragma unroll
                    for (int a = 0; a < 2; ++a)
#pragma unroll
                        for (int n = 0; n < 4; ++n) acc[a][n] = (f32x4){0.f, 0.f, 0.f, 0.f};
#pragma unroll
                    for (int ks_ = 0; ks_ < 4; ++ks_) {
                        bf16x8 tf[2];
#pragma unroll
                        for (int mb = 0; mb < 2; ++mb) tf[mb] = *(const LAS bf16x8*)(Pt + (mb * 16 + fr) * 1040 + (g_ * 128 + ks_ * 32 + fq * 8) * 2);
#pragma unroll
                        for (int nb = 0; nb < 4; ++nb) {
                            const bf16x8 wf = *(const bf16x8*)(pw + ((size_t)(g_ * 128 + dh * 64 + nb * 16 + fr)) * 128 + ks_ * 32 + fq * 8);
                            acc[0][nb] = __builtin_amdgcn_mfma_f32_16x16x32_bf16(wf, tf[0], acc[0][nb], 0, 0, 0);
                            acc[1][nb] = __builtin_amdgcn_mfma_f32_16x16x32_bf16(wf, tf[1], acc[1][nb], 0, 0, 0);
                        }
                    }
                    float ssq[2] = {0.f, 0.f};
#pragma unroll
                    for (int nb = 0; nb < 4; ++nb) { const f32x4 sc = *(const f32x4*)(pscale + g_ * 128 + dh * 64 + nb * 16 + 4 * fq);
#pragma unroll
                        for (int mb = 0; mb < 2; ++mb) { acc[mb][nb] = acc[mb][nb] * sc; const f32x4 v = acc[mb][nb]; ssq[mb] += (v.x * v.x + v.y * v.y) + (v.z * v.z + v.w * v.w); } }
#pragma unroll
                    for (int mb = 0; mb < 2; ++mb) { ssq[mb] += __shfl_xor(ssq[mb], 16); ssq[mb] += __shfl_xor(ssq[mb], 32); if (fq == 0) red[(mb * 16 + fr) * 8 + wave] = ssq[mb]; }
                    __syncthreads();
#pragma unroll
                    for (int mb = 0; mb < 2; ++mb) {
                        const LAS f32x4* rp = (const LAS f32x4*)(red + (mb * 16 + fr) * 8); const f32x4 ra = rp[0], rb = rp[1];
                        const float tot = ((ra.x + ra.y) + (ra.z + ra.w)) + ((rb.x + rb.y) + (rb.z + rb.w));
                        const float rstd = 1.f / sqrtf(tot * (1.f / 512.f) + RMS_EPS);
                        bf16_t* orow = MIX + (size_t)(r0 + mb * 16 + fr) * D + 1024 + g_ * 128 + dh * 64 + 4 * fq;
#pragma unroll
                        for (int nb = 0; nb < 4; ++nb) { const f32x4 gm = *(const f32x4*)(gmix + 1024 + g_ * 128 + dh * 64 + nb * 16 + 4 * fq); const f32x4 o = acc[mb][nb] * rstd * gm;
                            u32x2 w; w.x = cvt_pk_bf16(o.x, o.y); w.y = cvt_pk_bf16(o.z, o.w); *(u32x2*)(orow + nb * 16) = w; }
                    }
                    __syncthreads();
                }
            }
            {
                const float* ca = args.in[4] + (size_t)l * 3 * 1024;
                float a0[16], a1[16], a2[16], gm[16];
#pragma unroll
                for (int h = 0; h < 2; ++h)
#pragma unroll
                    for (int j = 0; j < 8; ++j) { const int c = h * 512 + lane * 8 + j; a0[h * 8 + j] = ca[c]; a1[h * 8 + j] = ca[1024 + c]; a2[h * 8 + j] = ca[2048 + c]; gm[h * 8 + j] = gmix[c]; }
                for (int run = gw; run < M / 16; run += NGW) {
                    const int r0 = run * 16, t0 = r0 & (SEQ - 1);
                    float up[16], uc[16], un[16];
#define LOAD_U(dst, r) do { _Pragma("unroll") for (int h = 0; h < 2; ++h) { const bf16_t* zp = Z + (size_t)(r) * NZ + h * 512 + lane * 8; \
                        float c_[8], v_[8]; unpack8(*(const u32x4*)(zp + ZC_GC), c_); unpack8(*(const u32x4*)(zp + ZC_V), v_); \
                        _Pragma("unroll") for (int j = 0; j < 8; ++j) dst[h * 8 + j] = c_[j] * v_[j]; } } while (0)
                    if (t0 > 0) { LOAD_U(up, r0 - 1); } else {
#pragma unroll
                        for (int j = 0; j < 16; ++j) up[j] = 0.f; }
                    LOAD_U(uc, r0);
                    for (int i = 0; i < 16; ++i) {
                        const int r = r0 + i;
                        if (t0 + i < SEQ - 1) { LOAD_U(un, r + 1); } else {
#pragma unroll
                            for (int j = 0; j < 16; ++j) un[j] = 0.f; }
                        float y[16]; float ss = 0.f;
#pragma unroll
                        for (int h = 0; h < 2; ++h) { float gb[8]; unpack8(*(const u32x4*)(Z + (size_t)r * NZ + ZC_GB + h * 512 + lane * 8), gb);
#pragma unroll
                            for (int j = 0; j < 8; ++j) { const int k = h * 8 + j; y[k] = gb[j] * (a0[k] * up[k] + a1[k] * uc[k] + a2[k] * un[k]); ss += y[k] * y[k]; } }
                        const float rstd = 1.f / sqrtf(wave_sum(ss) * (1.f / 1024.f) + RMS_EPS);
#pragma unroll
                        for (int h = 0; h < 2; ++h) { u32x4 w;
                            w.x = cvt_pk_bf16(y[h * 8 + 0] * rstd * gm[h * 8 + 0], y[h * 8 + 1] * rstd * gm[h * 8 + 1]); w.y = cvt_pk_bf16(y[h * 8 + 2] * rstd * gm[h * 8 + 2], y[h * 8 + 3] * rstd * gm[h * 8 + 3]);
                            w.z = cvt_pk_bf16(y[h * 8 + 4] * rstd * gm[h * 8 + 4], y[h * 8 + 5] * rstd * gm[h * 8 + 5]); w.w = cvt_pk_bf16(y[h * 8 + 6] * rstd * gm[h * 8 + 6], y[h * 8 + 7] * rstd * gm[h * 8 + 7]);
                            *(u32x4*)(MIX + (size_t)r * D + h * 512 + lane * 8) = w; }
#pragma unroll
                        for (int j = 0; j < 16; ++j) { up[j] = uc[j]; uc[j] = un[j]; }
                    }
#undef LOAD_U
                }
            }
        }
        grid.sync();
        if (PH(3)) {
            const int tid = launder(tid0), lane = tid & 63;
            const float* gmix = args.in[8] + (size_t)l * D;
            LAS unsigned char* M2p = lds;
            LAS unsigned char* tile = lds + 64 * 272;
            LAS float* red = (LAS float*)(lds + 64 * 272 + 64 * 2080);
            for (int i = tid; i < 64 * 128; i += 512) {
                const int o = i >> 7, ks_ = (i >> 5) & 3, kq = (i >> 3) & 3, e = (i >> 2) & 1, q = i & 3;
                const int ri = ks_ >> 1, t2 = (ks_ & 1) * 32 + 16 * e + 4 * kq + q;
                const float fr_ = (float)((o * t2) & 63) * (1.f / 64.f);
                const float v = (ri == 0 ? __builtin_amdgcn_cosf(fr_) : __builtin_amdgcn_sinf(fr_)) * 0.125f;
                *(LAS bf16_t*)(M2p + o * 272 + (i & 127) * 2) = f2bf(v);
            }
            __syncthreads();
            const int fr = lane & 15, fq = lane >> 4, qq = fr >> 2, pp = fr & 3;
            for (int it = bid; it < 512; it += G) {
                const int b = it >> 6, k1 = it & 63;
                const bf16_t* src = YP + (size_t)((b * 64 + k1) * 64) * 1024;
#pragma unroll
                for (int i = 0; i < 16; ++i) { const int idx = tid + 512 * i, row = idx >> 7, ch = idx & 127;
                    *(LAS u32x4*)(tile + row * 2080 + ch * 16) = *(const u32x4*)(src + (size_t)row * 1024 + ch * 8); }
                __syncthreads();
                f32x4 acc[4][4];
#pragma unroll
                for (int a = 0; a < 4; ++a)
#pragma unroll
                    for (int n = 0; n < 4; ++n) acc[a][n] = (f32x4){0.f, 0.f, 0.f, 0.f};
#pragma unroll
                for (int ks_ = 0; ks_ < 4; ++ks_) {
                    const int ri = ks_ >> 1, T0 = (ks_ & 1) * 32;
                    bf16x8 af[4];
#pragma unroll
                    for (int ob = 0; ob < 4; ++ob) af[ob] = *(const LAS bf16x8*)(M2p + (ob * 16 + fr) * 272 + (ks_ * 32 + fq * 8) * 2);
#pragma unroll
                    for (int nb = 0; nb < 4; ++nb) {
                        const int cb = (ri * 512 + 64 * wave + nb * 16 + 4 * pp) * 2;
                        const s16x4 lo = __builtin_amdgcn_ds_read_tr16_b64_v4i16((LAS s16x4*)(tile + (T0 + 4 * fq + qq) * 2080 + cb));
                        const s16x4 hi = __builtin_amdgcn_ds_read_tr16_b64_v4i16((LAS s16x4*)(tile + (T0 + 16 + 4 * fq + qq) * 2080 + cb));
                        const bf16x8 bf = (bf16x8){lo.x, lo.y, lo.z, lo.w, hi.x, hi.y, hi.z, hi.w};
#pragma unroll
                        for (int ob = 0; ob < 4; ++ob) acc[ob][nb] = __builtin_amdgcn_mfma_f32_16x16x32_bf16(af[ob], bf, acc[ob][nb], 0, 0, 0);
                    }
                }
#pragma unroll
                for (int ob = 0; ob < 4; ++ob)
#pragma unroll
                    for (int e = 0; e < 4; ++e) {
                        float s = 0.f;
#pragma unroll
                        for (int nb = 0; nb < 4; ++nb) s += acc[ob][nb][e] * acc[ob][nb][e];
                        s += __shfl_xor(s, 1); s += __shfl_xor(s, 2); s += __shfl_xor(s, 4); s += __shfl_xor(s, 8);
                        if (fr == 0) red[(ob * 16 + 4 * fq + e) * 8 + wave] = s;
                    }
                __syncthreads();
                float gmv[4];
#pragma unroll
                for (int nb = 0; nb < 4; ++nb) gmv[nb] = gmix[1536 + 64 * wave + nb * 16 + fr];
#pragma unroll
                for (int ob = 0; ob < 4; ++ob)
#pragma unroll
                    for (int e = 0; e < 4; ++e) {
                        const int k2 = ob * 16 + 4 * fq + e;
                        const LAS f32x4* rp = (const LAS f32x4*)(red + k2 * 8); const f32x4 ra = rp[0], rb = rp[1];
                        const float tot = ((ra.x + ra.y) + (ra.z + ra.w)) + ((rb.x + rb.y) + (rb.z + rb.w));
                        const float rstd = 1.f / sqrtf(tot * (1.f / 512.f) + RMS_EPS);
                        bf16_t* orow = MIX + (size_t)(b * SEQ + k1 + 64 * k2) * D + 1536 + 64 * wave + fr;
#pragma unroll
                        for (int nb = 0; nb < 4; ++nb) orow[nb * 16] = f2bf(acc[ob][nb][e] * rstd * gmv[nb]);
                    }
                __syncthreads();
            }
        }
        grid.sync();
        if (PH(4)) {
            pg8::Gemm g{MIX, (const bf16_t*)(ws + WS_WO) + (size_t)l * D * D, M, D, D, D}; pg8::StaticOrder S; S.init(M, D, G, bid);
            pg8::EpiBf16 E{Y1, D};
            pg8::gemm_phase<pg8::EpiBf16, true>(lds, g, S, E);
        }
        grid.sync();
        if (PH(5)) { const int lane = launder(tid0) & 63; for (int m = gw; m < M; m += NGW) ln_row<true>(X + (size_t)m * D, Y1 + (size_t)m * D, args.in[10] + (size_t)l * D, args.in[11] + (size_t)l * D, X + (size_t)m * D, XB + (size_t)m * D, lane); }
        grid.sync();
        if (PH(6)) {
            pg8::Gemm g{XB, (const bf16_t*)(ws + WS_WGU) + (size_t)l * NGU * D, M, NGU, D, D}; pg8::StaticOrder S; S.init(M, NGU, G, bid);
            pg8::EpiGU E{HB, DFF, args.in[14] + (size_t)l * 3 * DFF, args.in[15] + (size_t)l * DFF, DFF, EDG, EDG + EDGE_ELEMS, EDG + 2 * EDGE_ELEMS, (LAS float*)(lds + pg8::STAGE_BYTES)};
            pg8::gemm_phase<pg8::EpiGU, true>(lds, g, S, E);
        }
        grid.sync();
        if (PH(7)) {
            const int tid = launder(tid0);
            const float* cw = args.in[14] + (size_t)l * 3 * DFF;
            constexpr int NCH = DFF / 4;
            for (int idx = bid * 512 + tid; idx < 128 * 2 * NCH; idx += G * 512) {
                const int ch = idx % NCH, pe = idx / NCH, e = pe & 1, pm = pe >> 1, f = ch * 4;
                if (e == 0 ? ((pm & 15) == 0) : ((pm & 15) == 15)) continue;
                const size_t eo = (size_t)pe * DFF + f, no = (size_t)(e == 0 ? (pm - 1) * 2 + 1 : (pm + 1) * 2) * DFF + f;
                const f32x4 wv = *(const f32x4*)(cw + (e == 0 ? 0 : 2 * DFF) + f);
                const f32x4 y = *(const f32x4*)(EDG + EDGE_ELEMS + eo) + wv * *(const f32x4*)(EDG + no);
                const f32x4 o = pg8::gelu4(y) * *(const f32x4*)(EDG + 2 * EDGE_ELEMS + eo);
                u32x2 w; w.x = cvt_pk_bf16(o.x, o.y); w.y = cvt_pk_bf16(o.z, o.w);
                *(u32x2*)(HB + (size_t)(pm * 256 + (e == 0 ? 0 : 255)) * DFF + f) = w;
            }
        }
        grid.sync();
        if (PH(8)) {
            pg8::Gemm g{HB, (const bf16_t*)(ws + WS_WD) + (size_t)l * D * DFF, M, D, DFF, DFF}; pg8::StaticOrder S; S.init(M, D, G, bid);
            pg8::EpiBf16 E{XB, D};
            pg8::gemm_phase<pg8::EpiBf16, true>(lds, g, S, E);
        }
        grid.sync();
        if (PH(9)) { const int lane = launder(tid0) & 63; for (int m = gw; m < M; m += NGW) ln_row<true>(X + (size_t)m * D, XB + (size_t)m * D, args.in[17] + (size_t)l * D, args.in[18] + (size_t)l * D, X + (size_t)m * D, XB + (size_t)m * D, lane); }
        grid.sync();
    }
}

extern "C" void kernel_launch(void* const* d_in, const int* in_sizes, int n_in, void* d_out, int out_size, void* d_ws, size_t ws_size, hipStream_t stream) {
    static int grid_blocks = 0;
    if (grid_blocks == 0) {
        if (n_in != 19 || out_size != M * D || ws_size < WS_END) { fprintf(stderr, "kernel_launch: unexpected shapes (n_in %d, out %d, ws %zu, need %zu)\n", n_in, out_size, ws_size, (size_t)WS_END); grid_blocks = -1; return; }
        int dev = 0, cus = 0, per_cu = 0;
        (void)hipGetDevice(&dev);
        (void)hipDeviceGetAttribute(&cus, hipDeviceAttributeMultiprocessorCount, dev);
        if (hipFuncSetAttribute((const void*)fwd_kernel, hipFuncAttributeMaxDynamicSharedMemorySize, LDS_BYTES) != hipSuccess) { fprintf(stderr, "kernel_launch: hipFuncSetAttribute failed\n"); grid_blocks = -1; return; }
        if (hipOccupancyMaxActiveBlocksPerMultiprocessor(&per_cu, (const void*)fwd_kernel, 512, LDS_BYTES) != hipSuccess || per_cu < 1) { fprintf(stderr, "kernel_launch: occupancy query failed (%d)\n", per_cu); (void)hipGetLastError(); per_cu = 1; }
        grid_blocks = cus * per_cu;
        if (grid_blocks > 256) grid_blocks = 256;
    }
    if (grid_blocks < 0) return;
    Args a{};
    for (int i = 0; i < 19; ++i) a.in[i] = (const float*)d_in[i];
    a.out = (float*)d_out; a.ws = (unsigned char*)d_ws;
    void* kargs[] = {&a};
    hipError_t e = hipLaunchCooperativeKernel((const void*)fwd_kernel, dim3(grid_blocks), dim3(512), kargs, LDS_BYTES, stream);
    if (e != hipSuccess) fprintf(stderr, "cooperative launch failed: %s (grid %d)\n", hipGetErrorString(e), grid_blocks);
}
```

```cpp
#include <hip/hip_runtime.h>
#include <hip/hip_cooperative_groups.h>
#include <cstdio>
#include <cstdint>
namespace cg = cooperative_groups;

#define LAS __attribute__((address_space(3)))
typedef unsigned short bf16_t;
typedef short bf16x8 __attribute__((ext_vector_type(8)));
typedef short s16x4 __attribute__((ext_vector_type(4)));
typedef float f32x4 __attribute__((ext_vector_type(4)));
typedef float f32x2 __attribute__((ext_vector_type(2)));
typedef unsigned u32x4 __attribute__((ext_vector_type(4)));
typedef unsigned u32x2 __attribute__((ext_vector_type(2)));

constexpr int D = 2048, BATCH = 8, SEQ = 4096, DEPTH = 2, M = BATCH * SEQ;
constexpr int NZ = 4608;
constexpr int ZC_GB = 0, ZC_GC = 1024, ZC_V = 2048, ZC_POOL = 3072, ZC_FR = 3584, ZC_FI = 4096;
constexpr int DFF = 5632, NGU = 2 * DFF;
constexpr float ALPHA = 1.4142135623730951f;
constexpr float LN_EPS = 1e-5f, RMS_EPS = 1e-6f;

constexpr size_t MiB = 1u << 20;
constexpr size_t WS_WIN = 0;
constexpr size_t WS_WO = 36 * MiB;
constexpr size_t WS_WGU = 52 * MiB;
constexpr size_t WS_WD = 140 * MiB;
constexpr size_t WS_PW = 184 * MiB;
constexpr size_t WS_XB = 185 * MiB;
constexpr size_t WS_BIG = 313 * MiB;
constexpr size_t WS_Z = WS_BIG;
constexpr size_t WS_MIX = WS_BIG + 288 * MiB;
constexpr size_t WS_YP = WS_BIG + 416 * MiB;
constexpr size_t WS_EDGE = WS_BIG + 480 * MiB;
constexpr size_t EDGE_ELEMS = (size_t)128 * 2 * 5632;
constexpr size_t WS_END = WS_EDGE + 18 * MiB;

#ifndef PHMASK
#define PHMASK 0xFFFF
#endif
#define PH(n) ((PHMASK >> (n)) & 1)
constexpr int LDS_BYTES = 155648;

__device__ __forceinline__ unsigned cvt_pk_bf16(float lo, float hi) { unsigned r; asm volatile("v_cvt_pk_bf16_f32 %0, %1, %2" : "=v"(r) : "v"(lo), "v"(hi)); return r; }
__device__ __forceinline__ bf16_t f2bf(float x) { return (bf16_t)(cvt_pk_bf16(x, 0.f) & 0xffffu); }
__device__ __forceinline__ float bf_lo(unsigned w) { return __uint_as_float(w << 16); }
__device__ __forceinline__ float bf_hi(unsigned w) { return __uint_as_float(w & 0xffff0000u); }
__device__ __forceinline__ float bf2f(bf16_t b) { return __uint_as_float(((unsigned)b) << 16); }
__device__ __forceinline__ void unpack8(const u32x4 w, float (&f)[8]) {
    f[0] = bf_lo(w.x); f[1] = bf_hi(w.x); f[2] = bf_lo(w.y); f[3] = bf_hi(w.y); f[4] = bf_lo(w.z); f[5] = bf_hi(w.z); f[6] = bf_lo(w.w); f[7] = bf_hi(w.w);
}
__device__ __forceinline__ int launder(int x) { asm volatile("" : "+v"(x)); return x; }
__device__ __forceinline__ float wave_sum(float v) {
#pragma unroll
    for (int o = 1; o < 64; o <<= 1) v += __shfl_xor(v, o);
    return v;
}

namespace pg8 {
constexpr int BM = 256, BK = 64, HALF = 128, HTB = HALF * BK * 2, STAGE_BYTES = 8 * HTB, NXCD = 8, WGM = 8;
__host__ __device__ __forceinline__ int lds_byte(int r, int c) { const int st = (r >> 4) * 2 + (c >> 5), rr = r & 15, cc = c & 31, ob = rr * 64 + cc * 2; return st * 1024 + (ob ^ (((ob >> 9) & 1) << 5)); }
__host__ __device__ __forceinline__ void stage_rc(int b, int& R, int& C) { const int st = b / 1024, sb = b % 1024, swz = sb ^ (((sb >> 9) & 1) << 5); R = (st >> 1) * 16 + swz / 64; C = (st & 1) * 32 + (swz % 64) / 2; }
__host__ __device__ __forceinline__ int perm32(int rho) { const int n = rho >> 4, i = rho & 15; return 8 * (i >> 2) + 4 * n + (i & 3); }

struct Unit { int pm, pn; };
struct Gemm { const bf16_t* A; const bf16_t* Bt; int M, N, K, lda; };

struct StaticOrder {
    int nM, nN, nwg, G, c;
    __device__ void init(int M_, int N_, int G_, int c_) { nM = M_ / BM; nN = N_ / BM; nwg = nM * nN; G = G_; c = c_; }
    __device__ bool next(int i, Unit& u) const {
        const long L = (long)i * G + c; if (L >= nwg) return false;
        int wgid = (int)L; { const int q = nwg / NXCD, r = nwg % NXCD, xcd = wgid % NXCD, off = wgid / NXCD; wgid = (xcd < r ? xcd * (q + 1) : r * (q + 1) + (xcd - r) * q) + off; }
        const int nig = WGM * nN, gid = wgid / nig, fm = gid * WGM, gsz = (nM - fm) < WGM ? (nM - fm) : WGM;
        u.pm = fm + ((wgid % nig) % gsz); u.pn = (wgid % nig) / gsz; return true;
    }
};

struct EpiBf16 {
    static constexpr bool PERM = true;
    bf16_t* O; int ldc;
    __device__ __forceinline__ void operator()(const f32x4 (&acc)[2][2][4][2], const Unit& u, int wr, int wc, int fr, int fq) const {
        const int row0 = u.pm * BM + wr * 64 + fr; const int col0 = u.pn * BM + wc * 32 + 8 * fq;
#pragma unroll
        for (int ai = 0; ai < 2; ++ai)
#pragma unroll
            for (int m = 0; m < 4; ++m) { bf16_t* rowp = O + (size_t)(row0 + ai * HALF + m * 16) * ldc + col0;
#pragma unroll
                for (int bj = 0; bj < 2; ++bj) { const f32x4 v0 = acc[ai][bj][m][0], v1 = acc[ai][bj][m][1];
                    u32x4 w; w.x = cvt_pk_bf16(v0[0], v0[1]); w.y = cvt_pk_bf16(v0[2], v0[3]); w.z = cvt_pk_bf16(v1[0], v1[1]); w.w = cvt_pk_bf16(v1[2], v1[3]);
                    *(u32x4*)(rowp + bj * HALF) = w; } }
    }
};
struct EpiRes {
    static constexpr bool PERM = false;
    float* X; int ldc; float alpha;
    __device__ __forceinline__ void operator()(const f32x4 (&acc)[2][2][4][2], const Unit& u, int wr, int wc, int fr, int fq) const {
        const int row0 = u.pm * BM + wr * 64 + fr, col0 = u.pn * BM + wc * 32 + 4 * fq;
#pragma unroll
        for (int ai = 0; ai < 2; ++ai)
#pragma unroll
            for (int m = 0; m < 4; ++m) { float* rowp = X + (size_t)(row0 + ai * HALF + m * 16) * ldc + col0;
#pragma unroll
                for (int bj = 0; bj < 2; ++bj)
#pragma unroll
                    for (int n = 0; n < 2; ++n) { f32x4* p = (f32x4*)(rowp + bj * HALF + n * 16); const f32x4 xv = *p; *p = xv * alpha + acc[ai][bj][m][n]; }
                asm volatile("" ::: "memory"); }
    }
};

__device__ __forceinline__ f32x2 gelu_pk(f32x2 v) {
    const f32x2 av = __builtin_elementwise_abs(v), d = av * 0.2316418882f + 1.0f;
    f32x2 t; t.x = __builtin_amdgcn_rcpf(d.x); t.y = __builtin_amdgcn_rcpf(d.y);
    f32x2 q = t * 0.5307027145f + (-0.7265760135f); q = q * t + 0.7107068705f; q = q * t + (-0.142248368f); q = q * t + 0.127414796f; q = q * t;
    const f32x2 s = (v * v) * (-0.72134752044f);
    f32x2 e; e.x = __builtin_amdgcn_exp2f(s.x); e.y = __builtin_amdgcn_exp2f(s.y);
    const f32x2 m = v * (q * e), r = v - m;
    f32x2 o; o.x = v.x < 0.f ? m.x : r.x; o.y = v.y < 0.f ? m.y : r.y; return o;
}
__device__ __forceinline__ f32x4 gelu4(f32x4 v) { const f32x2 a = gelu_pk((f32x2){v.x, v.y}), b = gelu_pk((f32x2){v.z, v.w}); return (f32x4){a.x, a.y, b.x, b.y}; }
__device__ __forceinline__ float dpp_ror1(float x) { return __builtin_bit_cast(float, __builtin_amdgcn_update_dpp(0, __builtin_bit_cast(int, x), 0x121, 0xf, 0xf, false)); }
__device__ __forceinline__ float dpp_rol1(float x) { return __builtin_bit_cast(float, __builtin_amdgcn_update_dpp(0, __builtin_bit_cast(int, x), 0x12F, 0xf, 0xf, false)); }
__device__ __forceinline__ f32x4 ror4(f32x4 v) { return (f32x4){dpp_ror1(v.x), dpp_ror1(v.y), dpp_ror1(v.z), dpp_ror1(v.w)}; }
__device__ __forceinline__ f32x4 rol4(f32x4 v) { return (f32x4){dpp_rol1(v.x), dpp_rol1(v.y), dpp_rol1(v.z), dpp_rol1(v.w)}; }
__device__ __forceinline__ f32x4 sel4(bool c, f32x4 a, f32x4 b) { return (f32x4){c ? a.x : b.x, c ? a.y : b.y, c ? a.z : b.z, c ? a.w : b.w}; }

struct EpiGU {
    static constexpr bool PERM = true;
    bf16_t* H; int ldh; const float* cw; const float* cb; int dff; float* EG; float* EP; float* EU; LAS float* halo;
    __device__ __forceinline__ void operator()(const f32x4 (&acc)[2][2][4][2], const Unit& u, int wr, int wc, int fr, int fq) const {
        const int fl = wc * 32 + 8 * fq, f0 = u.pn * HALF + fl;
#pragma unroll
        for (int ai = 0; ai < 2; ++ai) { LAS float* hp = halo + ((ai * 2 + wr) * 2) * 128 + fl;
            if (fr == 0) { *(LAS f32x4*)(hp) = acc[ai][0][0][0]; *(LAS f32x4*)(hp + 4) = acc[ai][0][0][1]; }
            if (fr == 15) { *(LAS f32x4*)(hp + 128) = acc[ai][0][3][0]; *(LAS f32x4*)(hp + 132) = acc[ai][0][3][1]; } }
        asm volatile("s_waitcnt lgkmcnt(0)" ::: "memory"); __builtin_amdgcn_s_barrier(); asm volatile("" ::: "memory");
        const f32x4 zero4 = (f32x4){0.f, 0.f, 0.f, 0.f};
#pragma unroll
        for (int n = 0; n < 2; ++n) {
            const f32x4 w0 = *(const f32x4*)(cw + f0 + 4 * n), w1 = *(const f32x4*)(cw + dff + f0 + 4 * n), w2 = *(const f32x4*)(cw + 2 * dff + f0 + 4 * n), bb = *(const f32x4*)(cb + f0 + 4 * n);
#pragma unroll
            for (int ai = 0; ai < 2; ++ai) {
                const int idx = ai * 2 + wr;
                const f32x4 hprev = (idx > 0) ? *(const LAS f32x4*)(halo + ((idx - 1) * 2 + 1) * 128 + fl + 4 * n) : zero4;
                const f32x4 hnext = (idx < 3) ? *(const LAS f32x4*)(halo + ((idx + 1) * 2) * 128 + fl + 4 * n) : zero4;
                f32x4 rr[4], rl[4];
#pragma unroll
                for (int m = 0; m < 4; ++m) { rr[m] = ror4(acc[ai][0][m][n]); rl[m] = rol4(acc[ai][0][m][n]); }
#pragma unroll
                for (int m = 0; m < 4; ++m) {
                    const f32x4 pv = sel4(fr == 0, m > 0 ? rr[m > 0 ? m - 1 : 0] : hprev, rr[m]);
                    const f32x4 nx = sel4(fr == 15, m < 3 ? rl[m < 3 ? m + 1 : 3] : hnext, rl[m]);
                    const f32x4 y = w0 * pv + w1 * acc[ai][0][m][n] + w2 * nx + bb;
                    if (ai == 0 && m == 0) { if (wr == 0 && fr == 0) { const size_t eo = ((size_t)u.pm * 2 + 0) * dff + f0 + 4 * n; *(f32x4*)(EG + eo) = acc[0][0][0][n]; *(f32x4*)(EP + eo) = y; *(f32x4*)(EU + eo) = acc[0][1][0][n]; } }
                    if (ai == 1 && m == 3) { if (wr == 1 && fr == 15) { const size_t eo = ((size_t)u.pm * 2 + 1) * dff + f0 + 4 * n; *(f32x4*)(EG + eo) = acc[1][0][3][n]; *(f32x4*)(EP + eo) = y; *(f32x4*)(EU + eo) = acc[1][1][3][n]; } }
                    const f32x4 o = gelu4(y) * acc[ai][1][m][n];
                    u32x2 w; w.x = cvt_pk_bf16(o.x, o.y); w.y = cvt_pk_bf16(o.z, o.w);
                    *(u32x2*)(H + (size_t)(u.pm * BM + ai * HALF + wr * 64 + m * 16 + fr) * ldh + f0 + 4 * n) = w;
                }
            }
        }
    }
};

template <class Epi, bool ALIGN_EPI>
__device__ __forceinline__ void gemm_phase(LAS unsigned char* lds, const Gemm g, const StaticOrder& S, const Epi& E) {
    const int tid = launder(threadIdx.x), wid = __builtin_amdgcn_readfirstlane(tid >> 6), lane = tid & 63, wr = wid >> 2, wc = wid & 3, fr = lane & 15, fq = lane >> 4;
    const int K = g.K, nt = K / BK, lda = g.lda;
    unsigned voffA[2], voffB[2];
#pragma unroll
    for (int i = 0; i < 2; ++i) { int R, C; stage_rc(tid * 16 + i * 8192, R, C); const int Rb = Epi::PERM ? ((R & ~31) + perm32(R & 31)) : R;
        voffA[i] = (unsigned)(R * lda + C) * 2u; voffB[i] = (unsigned)(Rb * K + C) * 2u; }
    const size_t kstep = (size_t)(BK * 2);
    const size_t hstepA = (size_t)HALF * lda * 2, hstepB = (size_t)HALF * K * 2;
    const size_t tstepA = 2 * hstepA, tstepB = 2 * hstepB;
    const unsigned ldsw = (unsigned)wid * 1024u;
    const int aoff = lds_byte(wr * 64 + fr, fq * 8), boff = lds_byte(wc * 32 + fr, fq * 8);
#define PG8_SA(b, h) (((b) * 2 + (h)) * HTB)
#define PG8_SB(b, h) ((4 + (b) * 2 + (h)) * HTB)
#define PG8_STAGE(bufoff, gbase, voff) do { _Pragma("unroll") for (int _i = 0; _i < 2; ++_i) \
        __builtin_amdgcn_global_load_lds((const unsigned*)((const char*)(gbase) + (voff)[_i]), (LAS unsigned*)(lds + (bufoff) + ldsw + _i * 8192), 16, 0, 0); } while (0)
#define PG8_LDA(dst, b, h) do { _Pragma("unroll") for (int m = 0; m < 4; ++m) _Pragma("unroll") for (int k = 0; k < 2; ++k) dst[m][k] = *(const LAS bf16x8*)(lds + PG8_SA(b, h) + aoff + m * 2048 + k * 1024); } while (0)
#define PG8_LDB(dst, b, h) do { _Pragma("unroll") for (int n = 0; n < 2; ++n) _Pragma("unroll") for (int k = 0; k < 2; ++k) dst[n][k] = *(const LAS bf16x8*)(lds + PG8_SB(b, h) + boff + n * 2048 + k * 1024); } while (0)
#define PG8_MMA(ai, bj, At, Bt) do { __builtin_amdgcn_s_setprio(1); _Pragma("unroll") for (int m = 0; m < 4; ++m) _Pragma("unroll") for (int n = 0; n < 2; ++n) _Pragma("unroll") for (int k = 0; k < 2; ++k) \
        acc[ai][bj][m][n] = __builtin_amdgcn_mfma_f32_16x16x32_bf16(Bt[n][k], At[m][k], acc[ai][bj][m][n], 0, 0, 0); __builtin_amdgcn_s_setprio(0); } while (0)
#define PG8_WAIT_V(n) asm volatile("s_waitcnt vmcnt(" #n ")" ::: "memory")
#define PG8_WAIT_L(n) asm volatile("s_waitcnt lgkmcnt(" #n ")" ::: "memory")
#define PG8_BAR __builtin_amdgcn_s_barrier()
#define PG8_SCHED __builtin_amdgcn_sched_barrier(0)
    Unit cur, nxt; int ui = 0;
    if (!S.next(0, cur)) return;
    f32x4 acc[2][2][4][2];
#pragma unroll
    for (int a = 0; a < 2; ++a)
#pragma unroll
        for (int b = 0; b < 2; ++b)
#pragma unroll
            for (int m = 0; m < 4; ++m)
#pragma unroll
                for (int n = 0; n < 2; ++n) acc[a][b][m][n] = (f32x4){0.f, 0.f, 0.f, 0.f};
    bf16x8 At[4][2], B0[2][2], B1[2][2];
    const char* cA = (const char*)g.A + (size_t)cur.pm * tstepA; const char* cB = (const char*)g.Bt + (size_t)cur.pn * tstepB;
    PG8_STAGE(PG8_SB(0, 0), cB, voffB); PG8_STAGE(PG8_SB(0, 1), cB + hstepB, voffB); PG8_STAGE(PG8_SA(0, 0), cA, voffA); PG8_STAGE(PG8_SA(0, 1), cA + hstepA, voffA);
    if (wr == 1) PG8_BAR;
    PG8_WAIT_V(2); PG8_BAR;
    PG8_STAGE(PG8_SB(1, 0), cB + kstep, voffB); PG8_STAGE(PG8_SA(1, 0), cA + kstep, voffA); PG8_STAGE(PG8_SB(1, 1), cB + hstepB + kstep, voffB);
    PG8_WAIT_V(6); PG8_BAR;
    for (;;) {
        const bool has_next = S.next(ui + 1, nxt);
        const char* nA = has_next ? (const char*)g.A + (size_t)nxt.pm * tstepA : cA; const char* nB = has_next ? (const char*)g.Bt + (size_t)nxt.pn * tstepB : cB;
        for (int t = 0; t < nt; t += 2) {
            const bool last = (t == nt - 2);
            const char* a1 = cA + (size_t)(t + 1) * kstep;
            const char* a2 = last ? nA : cA + (size_t)(t + 2) * kstep; const char* b2 = last ? nB : cB + (size_t)(t + 2) * kstep;
            const char* a3 = a2 + kstep; const char* b3 = b2 + kstep;
            PG8_LDB(B0, 0, 0); PG8_LDB(B1, 0, 1); PG8_SCHED; PG8_LDA(At, 0, 0); PG8_STAGE(PG8_SA(1, 1), a1 + hstepA, voffA);
            PG8_WAIT_V(8); PG8_WAIT_L(0); PG8_BAR; PG8_MMA(0, 0, At, B0); PG8_MMA(0, 1, At, B1); PG8_BAR; PG8_SCHED;
            PG8_LDA(At, 0, 1); PG8_STAGE(PG8_SB(0, 0), b2, voffB); PG8_STAGE(PG8_SB(0, 1), b2 + hstepB, voffB); PG8_STAGE(PG8_SA(0, 0), a2, voffA);
            PG8_WAIT_V(8); PG8_WAIT_L(0); PG8_BAR; PG8_MMA(1, 0, At, B0); PG8_MMA(1, 1, At, B1); PG8_BAR; PG8_SCHED;
            PG8_LDB(B0, 1, 0); PG8_LDB(B1, 1, 1); PG8_SCHED; PG8_LDA(At, 1, 0); PG8_STAGE(PG8_SA(0, 1), a2 + hstepA, voffA);
            PG8_WAIT_V(8); PG8_WAIT_L(0); PG8_BAR; PG8_MMA(0, 0, At, B0); PG8_MMA(0, 1, At, B1); PG8_BAR; PG8_SCHED;
            PG8_LDA(At, 1, 1); PG8_STAGE(PG8_SB(1, 0), b3, voffB); PG8_STAGE(PG8_SB(1, 1), b3 + hstepB, voffB); PG8_STAGE(PG8_SA(1, 0), a3, voffA);
            PG8_WAIT_V(8); PG8_WAIT_L(0); PG8_BAR; PG8_MMA(1, 0, At, B0); PG8_MMA(1, 1, At, B1); PG8_BAR; PG8_SCHED;
        }
        if constexpr (ALIGN_EPI) { if (wr == 0) PG8_BAR; }
        E(acc, cur, wr, wc, fr, fq);
        if (!has_next) break;
#pragma unroll
        for (int a = 0; a < 2; ++a)
#pragma unroll
            for (int b = 0; b < 2; ++b)
#pragma unroll
                for (int m = 0; m < 4; ++m)
#pragma unroll
                    for (int n = 0; n < 2; ++n) acc[a][b][m][n] = (f32x4){0.f, 0.f, 0.f, 0.f};
        cur = nxt; cA = nA; cB = nB; ++ui;
        if constexpr (ALIGN_EPI) { if (wr == 1) PG8_BAR; }
    }
    PG8_WAIT_V(0);
    if constexpr (!ALIGN_EPI) { if (wr == 0) PG8_BAR; }
    PG8_BAR;
#undef PG8_SA
#undef PG8_SB
#undef PG8_STAGE
#undef PG8_LDA
#undef PG8_LDB
#undef PG8_MMA
#undef PG8_WAIT_V
#undef PG8_WAIT_L
#undef PG8_BAR
#undef PG8_SCHED
}
}

struct Args { const float* in[19]; float* out; unsigned char* ws; };

#define LDS_WAIT() asm volatile("s_waitcnt lgkmcnt(0)" ::: "memory")

__device__ __forceinline__ void p0_transpose_item(const float* W, int K, int pitch, int nblk, bf16_t* WT, int row_off, LAS float* scr, int item, int lane, int il = 0) {
    const int kb = item / nblk, nb = item % nblk, k0 = 64 * kb, n0 = 32 * nb;
    const int rbase = il ? ((n0 >> 7) * 256 + (n0 & 127) + (il == 2 ? 128 : 0)) : row_off + n0;
#pragma unroll 8
    for (int i = 0; i < 32; ++i) { const int kk = 2 * i + (lane >> 5); scr[kk * 33 + (lane & 31)] = W[(size_t)(k0 + kk) * pitch + n0 + (lane & 31)]; }
    LDS_WAIT(); asm volatile("" ::: "memory");
    const int c = lane & 7;
#pragma unroll
    for (int j = 0; j < 4; ++j) { const int n = (lane >> 3) + 8 * j; const LAS float* s = scr + (8 * c) * 33 + n;
        u32x4 o; o.x = cvt_pk_bf16(s[0 * 33], s[1 * 33]); o.y = cvt_pk_bf16(s[2 * 33], s[3 * 33]); o.z = cvt_pk_bf16(s[4 * 33], s[5 * 33]); o.w = cvt_pk_bf16(s[6 * 33], s[7 * 33]);
        *(u32x4*)(WT + (size_t)(rbase + n) * K + k0 + 8 * c) = o; }
    LDS_WAIT(); asm volatile("" ::: "memory");
}

template <int MODE>
__device__ __forceinline__ void ln_row(const float* xrow, const bf16_t* xbrow, const bf16_t* yrow, const float* g, const float* b, float* of, bf16_t* ob, int lane) {
    f32x4 v[8]; float s = 0.f;
    if (MODE == 1) {
        const u32x2* xr = (const u32x2*)xbrow + lane; const u32x2* yr = (const u32x2*)yrow + lane; u32x2 xv[8], yv[8];
#pragma unroll
        for (int j = 0; j < 8; ++j) { xv[j] = xr[64 * j]; yv[j] = yr[64 * j]; }
#pragma unroll
        for (int j = 0; j < 8; ++j) { v[j] = (f32x4){bf_lo(xv[j].x), bf_hi(xv[j].x), bf_lo(xv[j].y), bf_hi(xv[j].y)} * ALPHA + (f32x4){bf_lo(yv[j].x), bf_hi(yv[j].x), bf_lo(yv[j].y), bf_hi(yv[j].y)}; s += (v[j].x + v[j].y) + (v[j].z + v[j].w); }
    } else {
        const f32x4* xr = (const f32x4*)xrow + lane;
#pragma unroll
        for (int j = 0; j < 8; ++j) { v[j] = xr[64 * j]; s += (v[j].x + v[j].y) + (v[j].z + v[j].w); }
    }
    const float mean = wave_sum(s) * (1.f / D); float s2 = 0.f;
#pragma unroll
    for (int j = 0; j < 8; ++j) { v[j] = v[j] - mean; s2 += (v[j].x * v[j].x + v[j].y * v[j].y) + (v[j].z * v[j].z + v[j].w * v[j].w); }
    const float rstd = 1.f / sqrtf(wave_sum(s2) * (1.f / D) + LN_EPS);
    const f32x4* gp = (const f32x4*)g + lane; const f32x4* bp = (const f32x4*)b + lane;
#pragma unroll
    for (int j = 0; j < 8; ++j) { const f32x4 o = v[j] * rstd * gp[64 * j] + bp[64 * j];
        if (of) ((f32x4*)of + lane)[64 * j] = o;
        if (ob) { u32x2 w; w.x = cvt_pk_bf16(o.x, o.y); w.y = cvt_pk_bf16(o.z, o.w); ((u32x2*)ob + lane)[64 * j] = w; } }
}

__global__ void __launch_bounds__(512, 2) fwd_kernel(Args args) {
    extern __shared__ __attribute__((aligned(16))) unsigned char lds_raw[];
    LAS unsigned char* lds = (LAS unsigned char*)lds_raw;
    cg::grid_group grid = cg::this_grid();
    const int tid0 = threadIdx.x, wave = __builtin_amdgcn_readfirstlane(tid0 >> 6);
    const int G = gridDim.x, bid = blockIdx.x;
    const int gw = bid * 8 + wave, NGW = G * 8;
    unsigned char* ws = args.ws;
    float* X = args.out;
    bf16_t* XB = (bf16_t*)(ws + WS_XB);
    bf16_t* Z = (bf16_t*)(ws + WS_Z);
    bf16_t* MIX = (bf16_t*)(ws + WS_MIX);
    bf16_t* YP = (bf16_t*)(ws + WS_YP);
    bf16_t* HB = (bf16_t*)(ws + WS_BIG);
    bf16_t* Y2 = (bf16_t*)(ws + WS_BIG + 352 * MiB);
    float* EDG = (float*)(ws + WS_EDGE);
    bf16_t* PWT = (bf16_t*)(ws + WS_PW);
    bf16_t* Y1 = (bf16_t*)(ws + WS_Z);

    if (PH(0)) {
        const int tid = launder(tid0), lane = tid & 63;
        for (int it = bid; it < 256; it += G) {
            const int l = it >> 7, h = (it >> 5) & 3, cs = (it >> 4) & 1, kc = it & 15;
            LAS float* CW = (LAS float*)lds;
            {
                const int c = tid >> 2, d0 = (tid & 3) * 32;
                float a[32];
#pragma unroll
                for (int j = 0; j < 32; ++j) a[j] = 0.f;
                const float* Wf = args.in[7] + ((size_t)(l * 4 + h) * 128) * 128 + d0;
                for (int cp = 0; cp < 128; ++cp) {
                    const float fr_ = (float)((c * cp) & 127) * (1.f / 128.f);
                    const float tw = cs ? -__builtin_amdgcn_sinf(fr_) : __builtin_amdgcn_cosf(fr_);
                    const f32x4* wr_ = (const f32x4*)(Wf + (size_t)cp * 128);
#pragma unroll
                    for (int j = 0; j < 8; ++j) { const f32x4 w = wr_[j]; a[4 * j] += tw * w.x; a[4 * j + 1] += tw * w.y; a[4 * j + 2] += tw * w.z; a[4 * j + 3] += tw * w.w; }
                }
#pragma unroll
                for (int j = 0; j < 32; ++j) CW[c * 128 + d0 + j] = a[j] * 0.08838834764831845f;
            }
            __syncthreads();
            {
                const int k = kc * 128 + (tid & 127), d0 = (tid >> 7) * 32;
                float a[32];
#pragma unroll
                for (int j = 0; j < 32; ++j) a[j] = 0.f;
                const float* wrow = args.in[3] + ((size_t)l * D + k) * 4096 + 3584 + h * 128;
                for (int c4 = 0; c4 < 32; ++c4) {
                    const f32x4 wv = *(const f32x4*)(wrow + 4 * c4);
#pragma unroll
                    for (int cc = 0; cc < 4; ++cc) { const float av = wv[cc]; const LAS f32x4* cwp = (const LAS f32x4*)(CW + (4 * c4 + cc) * 128 + d0);
#pragma unroll
                        for (int j = 0; j < 8; ++j) { const f32x4 w = cwp[j]; a[4 * j] += av * w.x; a[4 * j + 1] += av * w.y; a[4 * j + 2] += av * w.z; a[4 * j + 3] += av * w.w; } }
                }
                bf16_t* dst = (bf16_t*)(ws + WS_WIN) + ((size_t)l * NZ + ZC_FR + cs * 512 + h * 128 + d0) * D + k;
#pragma unroll
                for (int j = 0; j < 32; ++j) dst[(size_t)j * D] = f2bf(a[j]);
            }
            __syncthreads();
        }
        {
            LAS float* scr = (LAS float*)(lds + wave * 16384);
            constexpr int I_IN = 32 * 112, I_O = 32 * 64, I_G = 32 * 176, I_D = 88 * 64, I_L = I_IN + I_O + 2 * I_G + I_D;
            for (int it = gw; it < 2 * I_L; it += NGW) {
                const int l = it / I_L; int r = it - l * I_L;
                if (r < I_IN) { p0_transpose_item(args.in[3] + (size_t)l * D * 4096, D, 4096, 112, (bf16_t*)(ws + WS_WIN) + (size_t)l * NZ * D, 0, scr, r, lane); continue; } r -= I_IN;
                if (r < I_O) { p0_transpose_item(args.in[9] + (size_t)l * D * D, D, D, 64, (bf16_t*)(ws + WS_WO) + (size_t)l * D * D, 0, scr, r, lane); continue; } r -= I_O;
                if (r < I_G) { p0_transpose_item(args.in[12] + (size_t)l * D * DFF, D, DFF, 176, (bf16_t*)(ws + WS_WGU) + (size_t)l * NGU * D, 0, scr, r, lane, 1); continue; } r -= I_G;
                if (r < I_G) { p0_transpose_item(args.in[13] + (size_t)l * D * DFF, D, DFF, 176, (bf16_t*)(ws + WS_WGU) + (size_t)l * NGU * D, DFF, scr, r, lane, 2); continue; } r -= I_G;
                p0_transpose_item(args.in[16] + (size_t)l * DFF * D, DFF, D, 64, (bf16_t*)(ws + WS_WD) + (size_t)l * D * DFF, 0, scr, r, lane);
            }
        }
        for (int i = bid * 512 + tid; i < 2 * 4 * 128 * 128; i += G * 512) { const int c = i & 127, d = (i >> 7) & 127, lg = i >> 14; PWT[i] = f2bf(args.in[5][((size_t)lg * 128 + c) * 128 + d]); }
        for (int m = gw; m < M; m += NGW) ln_row<0>(args.in[0] + (size_t)m * D, nullptr, nullptr, args.in[1], args.in[2], nullptr, XB + (size_t)m * D, lane);
    }
    grid.sync();

    for (int l = 0; l < DEPTH; ++l) {
        if (PH(1)) {
            pg8::Gemm g{XB, (const bf16_t*)(ws + WS_WIN) + (size_t)l * NZ * D, M, NZ, D, D}; pg8::StaticOrder S; S.init(M, NZ, G, bid);
            pg8::EpiBf16 E{Z, NZ};
            pg8::gemm_phase<pg8::EpiBf16, true>(lds, g, S, E);
        }
        grid.sync();
        if (PH(2)) {
            const int tid = launder(tid0), lane = tid & 63;
            const float* gmix = args.in[8] + (size_t)l * D;
            LAS unsigned char* M1p = lds;
            LAS unsigned char* tile = lds + 128 * 272;
            for (int i = tid; i < 128 * 128; i += 512) {
                const int o = i >> 7, ks_ = (i >> 5) & 3, kq = (i >> 3) & 3, e = (i >> 2) & 1, q = i & 3;
                const int ro = o >> 6, k1 = o & 63, ri = ks_ >> 1, t1 = (ks_ & 1) * 32 + 16 * e + 4 * kq + q;
                const float fr_ = (float)((k1 * t1) & 63) * (1.f / 64.f);
                const float c = __builtin_amdgcn_cosf(fr_) * 0.125f, s = __builtin_amdgcn_sinf(fr_) * 0.125f;
                const float v = (ro == ri) ? c : (ro == 0 ? s : -s);
                *(LAS bf16_t*)(M1p + o * 272 + (i & 127) * 2) = f2bf(v);
            }
            __syncthreads();
            const int fr = lane & 15, fq = lane >> 4, qq = fr >> 2, pp = fr & 3;
            for (int it = bid; it < 1024; it += G) {
                const int b = it >> 7, t2 = (it >> 1) & 63, half = it & 1;
#pragma unroll
                for (int i = 0; i < 8; ++i) { const int idx = tid + 512 * i, row = idx >> 6, ch = idx & 63, ri = ch >> 5, cc = ch & 31;
                    const u32x4 v = *(const u32x4*)(Z + (size_t)(b * SEQ + 64 * row + t2) * NZ + ZC_FR + ri * 512 + half * 256 + cc * 8);
                    *(LAS u32x4*)(tile + row * 1056 + ri * 512 + cc * 16) = v; }
                __syncthreads();
                f32x4 acc[8][2];
#pragma unroll
                for (int a = 0; a < 8; ++a) { acc[a][0] = (f32x4){0.f, 0.f, 0.f, 0.f}; acc[a][1] = (f32x4){0.f, 0.f, 0.f, 0.f}; }
#pragma unroll
                for (int ks_ = 0; ks_ < 4; ++ks_) {
                    const int ri = ks_ >> 1, T0 = (ks_ & 1) * 32;
                    bf16x8 bfrag[2];
#pragma unroll
                    for (int nb = 0; nb < 2; ++nb) {
                        const int cb = (ri * 256 + 32 * wave + nb * 16 + 4 * pp) * 2;
                        const s16x4 lo = __builtin_amdgcn_ds_read_tr16_b64_v4i16((LAS s16x4*)(tile + (T0 + 4 * fq + qq) * 1056 + cb));
                        const s16x4 hi = __builtin_amdgcn_ds_read_tr16_b64_v4i16((LAS s16x4*)(tile + (T0 + 16 + 4 * fq + qq) * 1056 + cb));
                        bfrag[nb] = (bf16x8){lo.x, lo.y, lo.z, lo.w, hi.x, hi.y, hi.z, hi.w};
                    }
#pragma unroll
                    for (int ob = 0; ob < 8; ++ob) {
                        const bf16x8 af = *(const LAS bf16x8*)(M1p + (ob * 16 + fr) * 272 + (ks_ * 32 + fq * 8) * 2);
                        acc[ob][0] = __builtin_amdgcn_mfma_f32_16x16x32_bf16(af, bfrag[0], acc[ob][0], 0, 0, 0);
                        acc[ob][1] = __builtin_amdgcn_mfma_f32_16x16x32_bf16(af, bfrag[1], acc[ob][1], 0, 0, 0);
                    }
                }
#pragma unroll
                for (int ob = 0; ob < 4; ++ob)
#pragma unroll
                    for (int e = 0; e < 4; ++e) {
                        const int k1 = ob * 16 + 4 * fq + e;
                        const float fr_ = (float)(k1 * t2) * (1.f / 4096.f);
                        const float ct = __builtin_amdgcn_cosf(fr_), st = __builtin_amdgcn_sinf(fr_);
                        bf16_t* dst = YP + ((size_t)((b * 64 + k1) * 64 + t2)) * 1024 + half * 256 + 32 * wave + fr;
#pragma unroll
                        for (int nb = 0; nb < 2; ++nb) {
                            const float yr = acc[ob][nb][e], yi = acc[ob + 4][nb][e];
                            dst[nb * 16] = f2bf(yr * ct + yi * st);
                            dst[512 + nb * 16] = f2bf(yi * ct - yr * st);
                        }
                    }
                __syncthreads();
            }
            {
                LAS unsigned char* Ht = lds;
                LAS unsigned char* Pt = lds + 48 * 1040;
                LAS float* red = (LAS float*)(lds + 48 * 1040 + 32 * 1040);
                const bf16_t* pw = PWT + (size_t)l * 4 * 128 * 128;
                const float* pscale = args.in[6] + (size_t)l * 512;
                const int g_ = wave >> 1, dh = wave & 1;
                for (int it = bid; it < M / 32; it += G) {
                    const int r0 = it * 32, t0 = r0 & (SEQ - 1);
#pragma unroll
                    for (int i = 0; i < 6; ++i) { const int idx = tid + 512 * i, row = idx >> 6, ch = idx & 63; const int t = t0 - 8 + row;
                        u32x4 v = (u32x4){0u, 0u, 0u, 0u};
                        if (t >= 0 && t < SEQ) v = *(const u32x4*)(Z + (size_t)(r0 - 8 + row) * NZ + ZC_POOL + ch * 8);
                        *(LAS u32x4*)(Ht + row * 1040 + ch * 16) = v; }
                    __syncthreads();
                    {
                        const int c = tid, gi = c >> 7, hf = 1 << gi;
                        float s = 0.f;
                        for (int j = -hf; j < hf; ++j) s += bf2f(*(const LAS bf16_t*)(Ht + (8 + j) * 1040 + c * 2));
                        for (int tt = 0; tt < 32; ++tt) {
                            const int t = t0 + tt;
                            const int hi_ = (t + hf < SEQ) ? t + hf : SEQ, lo_ = (t - hf > 0) ? t - hf : 0;
                            const float cnt = (float)(hi_ - lo_);
                            const float hc = bf2f(*(const LAS bf16_t*)(Ht + (8 + tt) * 1040 + c * 2));
                            *(LAS bf16_t*)(Pt + tt * 1040 + c * 2) = f2bf(s / cnt - hc);
                            s += bf2f(*(const LAS bf16_t*)(Ht + (8 + tt + hf) * 1040 + c * 2)) - bf2f(*(const LAS bf16_t*)(Ht + (8 + tt - hf) * 1040 + c * 2));
                        }
                    }
                    __syncthreads();
                    f32x4 acc[2][4];
#pragma unroll
                    for (int a = 0; a < 2; ++a)
#pragma unroll
                        for (int n = 0; n < 4; ++n) acc[a][n] = (f32x4){0.f, 0.f, 0.f, 0.f};
#pragma unroll
                    for (int ks_ = 0; ks_ < 4; ++ks_) {
                        bf16x8 tf[2];
#pragma unroll
                        for (int mb = 0; mb < 2; ++mb) tf[mb] = *(const LAS bf16x8*)(Pt + (mb * 16 + fr) * 1040 + (g_ * 128 + ks_ * 32 + fq * 8) * 2);
#pragma unroll
                        for (int nb = 0; nb < 4; ++nb) {
                            const bf16x8 wf = *(const bf16x8*)(pw + ((size_t)(g_ * 128 + dh * 64 + nb * 16 + fr)) * 128 + ks_ * 32 + fq * 8);
                            acc[0][nb] = __builtin_amdgcn_mfma_f32_16x16x32_bf16(wf, tf[0], acc[0][nb], 0, 0, 0);
                            acc[1][nb] = __builtin_amdgcn_mfma_f32_16x16x32_bf16(wf, tf[1], acc[1][nb], 0, 0, 0);
                        }
                    }
                    float ssq[2] = {0.f, 0.f};
#pragma unroll
                    for (int nb = 0; nb < 4; ++nb) { const f32x4 sc = *(const f32x4*)(pscale + g_ * 128 + dh * 64 + nb * 16 + 4 * fq);
#pragma unroll
                        for (int mb = 0; mb < 2; ++mb) { acc[mb][nb] = acc[mb][nb] * sc; const f32x4 v = acc[mb][nb]; ssq[mb] += (v.x * v.x + v.y * v.y) + (v.z * v.z + v.w * v.w); } }
#pragma unroll
                    for (int mb = 0; mb < 2; ++mb) { ssq[mb] += __shfl_xor(ssq[mb], 16); ssq[mb] += __shfl_xor(ssq[mb], 32); if (fq == 0) red[(mb * 16 + fr) * 8 + wave] = ssq[mb]; }
                    __syncthreads();
#pragma unroll
                    for (int mb = 0; mb < 2; ++mb) {
                        const LAS f32x4* rp = (const LAS f32x4*)(red + (mb * 16 + fr) * 8); const f32x4 ra = rp[0], rb = rp[1];
                        const float tot = ((ra.x + ra.y) + (ra.z + ra.w)) + ((rb.x + rb.y) + (rb.z + rb.w));
                        const float rstd = 1.f / sqrtf(tot * (1.f / 512.f) + RMS_EPS);
                        bf16_t* orow = MIX + (size_t)(r0 + mb * 16 + fr) * D + 1024 + g_ * 128 + dh * 64 + 4 * fq;
#pragma unroll
                        for (int nb = 0; nb < 4; ++nb) { const f32x4 gm = *(const f32x4*)(gmix + 1024 + g_ * 128 + dh * 64 + nb * 16 + 4 * fq); const f32x4 o = acc[mb][nb] * rstd * gm;
                            u32x2 w; w.x = cvt_pk_bf16(o.x, o.y); w.y = cvt_pk_bf16(o.z, o.w); *(u32x2*)(orow + nb * 16) = w; }
                    }
                    __syncthreads();
                }
            }
            {
                const float* ca = args.in[4] + (size_t)l * 3 * 1024;
                float a0[16], a1[16], a2[16], gm[16];
#pragma unroll
                for (int h = 0; h < 2; ++h)
#pragma unroll
                    for (int j = 0; j < 8; ++j) { const int c = h * 512 + lane * 8 + j; a0[h * 8 + j] = ca[c]; a1[h * 8 + j] = ca[1024 + c]; a2[h * 8 + j] = ca[2048 + c]; gm[h * 8 + j] = gmix[c]; }
                for (int run = gw; run < M / 16; run += NGW) {
                    const int r0 = run * 16, t0 = r0 & (SEQ - 1);
                    float up[16], uc[16], un[16];
#define LOAD_U(dst, r) do { _Pragma("unroll") for (int h = 0; h < 2; ++h) { const bf16_t* zp = Z + (size_t)(r) * NZ + h * 512 + lane * 8; \
                        float c_[8], v_[8]; unpack8(*(const u32x4*)(zp + ZC_GC), c_); unpack8(*(const u32x4*)(zp + ZC_V), v_); \
                        _Pragma("unroll") for (int j = 0; j < 8; ++j) dst[h * 8 + j] = c_[j] * v_[j]; } } while (0)
                    if (t0 > 0) { LOAD_U(up, r0 - 1); } else {
#pragma unroll
                        for (int j = 0; j < 16; ++j) up[j] = 0.f; }
                    LOAD_U(uc, r0);
                    for (int i = 0; i < 16; ++i) {
                        const int r = r0 + i;
                        if (t0 + i < SEQ - 1) { LOAD_U(un, r + 1); } else {
#pragma unroll
                            for (int j = 0; j < 16; ++j) un[j] = 0.f; }
                        float y[16]; float ss = 0.f;
#pragma unroll
                        for (int h = 0; h < 2; ++h) { float gb[8]; unpack8(*(const u32x4*)(Z + (size_t)r * NZ + ZC_GB + h * 512 + lane * 8), gb);
#pragma unroll
                            for (int j = 0; j < 8; ++j) { const int k = h * 8 + j; y[k] = gb[j] * (a0[k] * up[k] + a1[k] * uc[k] + a2[k] * un[k]); ss += y[k] * y[k]; } }
                        const float rstd = 1.f / sqrtf(wave_sum(ss) * (1.f / 1024.f) + RMS_EPS);
#pragma unroll
                        for (int h = 0; h < 2; ++h) { u32x4 w;
                            w.x = cvt_pk_bf16(y[h * 8 + 0] * rstd * gm[h * 8 + 0], y[h * 8 + 1] * rstd * gm[h * 8 + 1]); w.y = cvt_pk_bf16(y[h * 8 + 2] * rstd * gm[h * 8 + 2], y[h * 8 + 3] * rstd * gm[h * 8 + 3]);
                            w.z = cvt_pk_bf16(y[h * 8 + 4] * rstd * gm[h * 8 + 4], y[h * 8 + 5] * rstd * gm[h * 8 + 5]); w.w = cvt_pk_bf16(y[h * 8 + 6] * rstd * gm[h * 8 + 6], y[h * 8 + 7] * rstd * gm[h * 8 + 7]);
                            *(u32x4*)(MIX + (size_t)r * D + h * 512 + lane * 8) = w; }
#pragma unroll
                        for (int j = 0; j < 16; ++j) { up[j] = uc[j]; uc[j] = un[j]; }
                    }
#undef LOAD_U
                }
            }
        }
        grid.sync();
        if (PH(3)) {
            const int tid = launder(tid0), lane = tid & 63;
            const float* gmix = args.in[8] + (size_t)l * D;
            LAS unsigned char* M2p = lds;
            LAS unsigned char* tile = lds + 64 * 272;
            LAS float* red = (LAS float*)(lds + 64 * 272 + 64 * 2080);
            for (int i = tid; i < 64 * 128; i += 512) {
                const int o = i >> 7, ks_ = (i >> 5) & 3, kq = (i >> 3) & 3, e = (i >> 2) & 1, q = i & 3;
                const int ri = ks_ >> 1, t2 = (ks_ & 1) * 32 + 16 * e + 4 * kq + q;
                const float fr_ = (float)((o * t2) & 63) * (1.f / 64.f);
                const float v = (ri == 0 ? __builtin_amdgcn_cosf(fr_) : __builtin_amdgcn_sinf(fr_)) * 0.125f;
                *(LAS bf16_t*)(M2p + o * 272 + (i & 127) * 2) = f2bf(v);
            }
            __syncthreads();
            const int fr = lane & 15, fq = lane >> 4, qq = fr >> 2, pp = fr & 3;
            for (int it = bid; it < 512; it += G) {
                const int b = it >> 6, k1 = it & 63;
                const bf16_t* src = YP + (size_t)((b * 64 + k1) * 64) * 1024;
#pragma unroll
                for (int i = 0; i < 16; ++i) { const int idx = tid + 512 * i, row = idx >> 7, ch = idx & 127;
                    *(LAS u32x4*)(tile + row * 2080 + ch * 16) = *(const u32x4*)(src + (size_t)row * 1024 + ch * 8); }
                __syncthreads();
                f32x4 acc[4][4];
#pragma unroll
                for (int a = 0; a < 4; ++a)
#pragma unroll
                    for (int n = 0; n < 4; ++n) acc[a][n] = (f32x4){0.f, 0.f, 0.f, 0.f};
#pragma unroll
                for (int ks_ = 0; ks_ < 4; ++ks_) {
                    const int ri = ks_ >> 1, T0 = (ks_ & 1) * 32;
                    bf16x8 af[4];
#pragma unroll
                    for (int ob = 0; ob < 4; ++ob) af[ob] = *(const LAS bf16x8*)(M2p + (ob * 16 + fr) * 272 + (ks_ * 32 + fq * 8) * 2);
#pragma unroll
                    for (int nb = 0; nb < 4; ++nb) {
                        const int cb = (ri * 512 + 64 * wave + nb * 16 + 4 * pp) * 2;
                        const s16x4 lo = __builtin_amdgcn_ds_read_tr16_b64_v4i16((LAS s16x4*)(tile + (T0 + 4 * fq + qq) * 2080 + cb));
                        const s16x4 hi = __builtin_amdgcn_ds_read_tr16_b64_v4i16((LAS s16x4*)(tile + (T0 + 16 + 4 * fq + qq) * 2080 + cb));
                        const bf16x8 bf = (bf16x8){lo.x, lo.y, lo.z, lo.w, hi.x, hi.y, hi.z, hi.w};
#pragma unroll
                        for (int ob = 0; ob < 4; ++ob) acc[ob][nb] = __builtin_amdgcn_mfma_f32_16x16x32_bf16(af[ob], bf, acc[ob][nb], 0, 0, 0);
                    }
                }
#pragma unroll
                for (int ob = 0; ob < 4; ++ob)
#pragma unroll
                    for (int e = 0; e < 4; ++e) {
                        float s = 0.f;
#pragma unroll
                        for (int nb = 0; nb < 4; ++nb) s += acc[ob][nb][e] * acc[ob][nb][e];
                        s += __shfl_xor(s, 1); s += __shfl_xor(s, 2); s += __shfl_xor(s, 4); s += __shfl_xor(s, 8);
                        if (fr == 0) red[(ob * 16 + 4 * fq + e) * 8 + wave] = s;
                    }
                __syncthreads();
                float gmv[4];
#pragma unroll
                for (int nb = 0; nb < 4; ++nb) gmv[nb] = gmix[1536 + 64 * wave + nb * 16 + fr];
#pragma unroll
                for (int ob = 0; ob < 4; ++ob)
#pragma unroll
                    for (int e = 0; e < 4; ++e) {
                        const int k2 = ob * 16 + 4 * fq + e;
                        const LAS f32x4* rp = (const LAS f32x4*)(red + k2 * 8); const f32x4 ra = rp[0], rb = rp[1];
                        const float tot = ((ra.x + ra.y) + (ra.z + ra.w)) + ((rb.x + rb.y) + (rb.z + rb.w));
                        const float rstd = 1.f / sqrtf(tot * (1.f / 512.f) + RMS_EPS);
                        bf16_t* orow = MIX + (size_t)(b * SEQ + k1 + 64 * k2) * D + 1536 + 64 * wave + fr;
#pragma unroll
                        for (int nb = 0; nb < 4; ++nb) orow[nb * 16] = f2bf(acc[ob][nb][e] * rstd * gmv[nb]);
                    }
                __syncthreads();
            }
        }
        grid.sync();
        if (PH(4)) {
            pg8::Gemm g{MIX, (const bf16_t*)(ws + WS_WO) + (size_t)l * D * D, M, D, D, D}; pg8::StaticOrder S; S.init(M, D, G, bid);
            pg8::EpiBf16 E{Y1, D};
            pg8::gemm_phase<pg8::EpiBf16, true>(lds, g, S, E);
        }
        grid.sync();
        if (PH(5)) { const int lane = launder(tid0) & 63; for (int m = gw; m < M; m += NGW) ln_row<1>(nullptr, XB + (size_t)m * D, Y1 + (size_t)m * D, args.in[10] + (size_t)l * D, args.in[11] + (size_t)l * D, nullptr, XB + (size_t)m * D, lane); }
        grid.sync();
        if (PH(6)) {
            pg8::Gemm g{XB, (const bf16_t*)(ws + WS_WGU) + (size_t)l * NGU * D, M, NGU, D, D}; pg8::StaticOrder S; S.init(M, NGU, G, bid);
            pg8::EpiGU E{HB, DFF, args.in[14] + (size_t)l * 3 * DFF, args.in[15] + (size_t)l * DFF, DFF, EDG, EDG + EDGE_ELEMS, EDG + 2 * EDGE_ELEMS, (LAS float*)(lds + pg8::STAGE_BYTES)};
            pg8::gemm_phase<pg8::EpiGU, true>(lds, g, S, E);
        }
        grid.sync();
        if (PH(7)) {
            const int tid = launder(tid0);
            const float* cw = args.in[14] + (size_t)l * 3 * DFF;
            constexpr int NCH = DFF / 4;
            for (int idx = bid * 512 + tid; idx < 128 * 2 * NCH; idx += G * 512) {
                const int ch = idx % NCH, pe = idx / NCH, e = pe & 1, pm = pe >> 1, f = ch * 4;
                if (e == 0 ? ((pm & 15) == 0) : ((pm & 15) == 15)) continue;
                const size_t eo = (size_t)pe * DFF + f, no = (size_t)(e == 0 ? (pm - 1) * 2 + 1 : (pm + 1) * 2) * DFF + f;
                const f32x4 wv = *(const f32x4*)(cw + (e == 0 ? 0 : 2 * DFF) + f);
                const f32x4 y = *(const f32x4*)(EDG + EDGE_ELEMS + eo) + wv * *(const f32x4*)(EDG + no);
                const f32x4 o = pg8::gelu4(y) * *(const f32x4*)(EDG + 2 * EDGE_ELEMS + eo);
                u32x2 w; w.x = cvt_pk_bf16(o.x, o.y); w.y = cvt_pk_bf16(o.z, o.w);
                *(u32x2*)(HB + (size_t)(pm * 256 + (e == 0 ? 0 : 255)) * DFF + f) = w;
            }
        }
        grid.sync();
        if (PH(8)) {
            pg8::Gemm g{HB, (const bf16_t*)(ws + WS_WD) + (size_t)l * D * DFF, M, D, DFF, DFF}; pg8::StaticOrder S; S.init(M, D, G, bid);
            pg8::EpiBf16 E{Y2, D};
            pg8::gemm_phase<pg8::EpiBf16, true>(lds, g, S, E);
        }
        grid.sync();
        if (PH(9)) { const int lane = launder(tid0) & 63; float* const fo = (l == DEPTH - 1) ? X : nullptr; bf16_t* const bo = (l == DEPTH - 1) ? nullptr : XB;
            for (int m = gw; m < M; m += NGW) ln_row<1>(nullptr, XB + (size_t)m * D, Y2 + (size_t)m * D, args.in[17] + (size_t)l * D, args.in[18] + (size_t)l * D, fo ? fo + (size_t)m * D : nullptr, bo ? bo + (size_t)m * D : nullptr, lane); }
        grid.sync();
    }
}

extern "C" void kernel_launch(void* const* d_in, const int* in_sizes, int n_in, void* d_out, int out_size, void* d_ws, size_t ws_size, hipStream_t stream) {
    static int grid_blocks = 0;
    if (grid_blocks == 0) {
        if (n_in != 19 || out_size != M * D || ws_size < WS_END) { fprintf(stderr, "kernel_launch: unexpected shapes (n_in %d, out %d, ws %zu, need %zu)\n", n_in, out_size, ws_size, (size_t)WS_END); grid_blocks = -1; return; }
        int dev = 0, cus = 0, per_cu = 0;
        (void)hipGetDevice(&dev);
        (void)hipDeviceGetAttribute(&cus, hipDeviceAttributeMultiprocessorCount, dev);
        if (hipFuncSetAttribute((const void*)fwd_kernel, hipFuncAttributeMaxDynamicSharedMemorySize, LDS_BYTES) != hipSuccess) { fprintf(stderr, "kernel_launch: hipFuncSetAttribute failed\n"); grid_blocks = -1; return; }
        if (hipOccupancyMaxActiveBlocksPerMultiprocessor(&per_cu, (const void*)fwd_kernel, 512, LDS_BYTES) != hipSuccess || per_cu < 1) { fprintf(stderr, "kernel_launch: occupancy query failed (%d)\n", per_cu); (void)hipGetLastError(); per_cu = 1; }
        grid_blocks = cus * per_cu;
        if (grid_blocks > 256) grid_blocks = 256;
    }
    if (grid_blocks < 0) return;
    Args a{};
    for (int i = 0; i < 19; ++i) a.in[i] = (const float*)d_in[i];
    a.out = (float*)d_out; a.ws = (unsigned char*)d_ws;
    void* kargs[] = {&a};
    hipError_t e = hipLaunchCooperativeKernel((const void*)fwd_kernel, dim3(grid_blocks), dim3(512), kargs, LDS_BYTES, stream);
    if (e != hipSuccess) fprintf(stderr, "cooperative launch failed: %s (grid %d)\n", hipGetErrorString(e), grid_blocks);
}
```

```cpp
#include <hip/hip_runtime.h>
#include <hip/hip_cooperative_groups.h>
#include <cstdio>
#include <cstdint>
namespace cg = cooperative_groups;

#define LAS __attribute__((address_space(3)))
typedef unsigned short bf16_t;
typedef short bf16x8 __attribute__((ext_vector_type(8)));
typedef short s16x4 __attribute__((ext_vector_type(4)));
typedef float f32x4 __attribute__((ext_vector_type(4)));
typedef float f32x2 __attribute__((ext_vector_type(2)));
typedef unsigned u32x4 __attribute__((ext_vector_type(4)));
typedef unsigned u32x2 __attribute__((ext_vector_type(2)));

constexpr int D = 2048, BATCH = 8, SEQ = 4096, DEPTH = 2, M = BATCH * SEQ;
constexpr int NZ = 4608;
constexpr int ZC_GB = 0, ZC_GC = 1024, ZC_V = 2048, ZC_POOL = 3072, ZC_FR = 3584, ZC_FI = 4096;
constexpr int DFF = 5632, NGU = 2 * DFF;
constexpr float ALPHA = 1.4142135623730951f;
constexpr float LN_EPS = 1e-5f, RMS_EPS = 1e-6f;

constexpr size_t MiB = 1u << 20;
constexpr size_t WS_WIN = 0;
constexpr size_t WS_WO = 36 * MiB;
constexpr size_t WS_WGU = 52 * MiB;
constexpr size_t WS_WD = 140 * MiB;
constexpr size_t WS_PW = 184 * MiB;
constexpr size_t WS_XB = 185 * MiB;
constexpr size_t WS_BIG = 313 * MiB;
constexpr size_t WS_Z = WS_BIG;
constexpr size_t WS_MIX = WS_BIG + 288 * MiB;
constexpr size_t WS_YP = WS_BIG + 416 * MiB;
constexpr size_t WS_EDGE = WS_BIG + 480 * MiB;
constexpr size_t EDGE_ELEMS = (size_t)128 * 2 * 5632;
constexpr size_t WS_BAR = WS_EDGE + 18 * MiB;
constexpr size_t WS_END = WS_BAR + 1 * MiB;

#ifndef PHMASK
#define PHMASK 0xFFFF
#endif
#define PH(n) ((PHMASK >> (n)) & 1)
constexpr int LDS_BYTES = 155648;

__device__ __forceinline__ unsigned cvt_pk_bf16(float lo, float hi) { unsigned r; asm volatile("v_cvt_pk_bf16_f32 %0, %1, %2" : "=v"(r) : "v"(lo), "v"(hi)); return r; }
__device__ __forceinline__ bf16_t f2bf(float x) { return (bf16_t)(cvt_pk_bf16(x, 0.f) & 0xffffu); }
__device__ __forceinline__ float bf_lo(unsigned w) { return __uint_as_float(w << 16); }
__device__ __forceinline__ float bf_hi(unsigned w) { return __uint_as_float(w & 0xffff0000u); }
__device__ __forceinline__ float bf2f(bf16_t b) { return __uint_as_float(((unsigned)b) << 16); }
__device__ __forceinline__ void unpack8(const u32x4 w, float (&f)[8]) {
    f[0] = bf_lo(w.x); f[1] = bf_hi(w.x); f[2] = bf_lo(w.y); f[3] = bf_hi(w.y); f[4] = bf_lo(w.z); f[5] = bf_hi(w.z); f[6] = bf_lo(w.w); f[7] = bf_hi(w.w);
}
__device__ __forceinline__ int launder(int x) { asm volatile("" : "+v"(x)); return x; }
__device__ __forceinline__ float wave_sum(float v) {
#pragma unroll
    for (int o = 1; o < 64; o <<= 1) v += __shfl_xor(v, o);
    return v;
}

namespace pg8 {
constexpr int BM = 256, BK = 64, HALF = 128, HTB = HALF * BK * 2, STAGE_BYTES = 8 * HTB, NXCD = 8, WGM = 8;
__host__ __device__ __forceinline__ int lds_byte(int r, int c) { const int st = (r >> 4) * 2 + (c >> 5), rr = r & 15, cc = c & 31, ob = rr * 64 + cc * 2; return st * 1024 + (ob ^ (((ob >> 9) & 1) << 5)); }
__host__ __device__ __forceinline__ void stage_rc(int b, int& R, int& C) { const int st = b / 1024, sb = b % 1024, swz = sb ^ (((sb >> 9) & 1) << 5); R = (st >> 1) * 16 + swz / 64; C = (st & 1) * 32 + (swz % 64) / 2; }
__host__ __device__ __forceinline__ int perm32(int rho) { const int n = rho >> 4, i = rho & 15; return 8 * (i >> 2) + 4 * n + (i & 3); }

struct Unit { int pm, pn; };
struct Gemm { const bf16_t* A; const bf16_t* Bt; int M, N, K, lda; };

struct StaticOrder {
    int nM, nN, nwg, G, c;
    __device__ void init(int M_, int N_, int G_, int c_) { nM = M_ / BM; nN = N_ / BM; nwg = nM * nN; G = G_; c = c_; }
    __device__ bool next(int i, Unit& u) const {
        const long L = (long)i * G + c; if (L >= nwg) return false;
        int wgid = (int)L; { const int q = nwg / NXCD, r = nwg % NXCD, xcd = wgid % NXCD, off = wgid / NXCD; wgid = (xcd < r ? xcd * (q + 1) : r * (q + 1) + (xcd - r) * q) + off; }
        const int nig = WGM * nN, gid = wgid / nig, fm = gid * WGM, gsz = (nM - fm) < WGM ? (nM - fm) : WGM;
        u.pm = fm + ((wgid % nig) % gsz); u.pn = (wgid % nig) / gsz; return true;
    }
};

struct EpiBf16 {
    static constexpr bool PERM = true;
    bf16_t* O; int ldc;
    __device__ __forceinline__ void operator()(const f32x4 (&acc)[2][2][4][2], const Unit& u, int wr, int wc, int fr, int fq) const {
        const int row0 = u.pm * BM + wr * 64 + fr; const int col0 = u.pn * BM + wc * 32 + 8 * fq;
#pragma unroll
        for (int ai = 0; ai < 2; ++ai)
#pragma unroll
            for (int m = 0; m < 4; ++m) { bf16_t* rowp = O + (size_t)(row0 + ai * HALF + m * 16) * ldc + col0;
#pragma unroll
                for (int bj = 0; bj < 2; ++bj) { const f32x4 v0 = acc[ai][bj][m][0], v1 = acc[ai][bj][m][1];
                    u32x4 w; w.x = cvt_pk_bf16(v0[0], v0[1]); w.y = cvt_pk_bf16(v0[2], v0[3]); w.z = cvt_pk_bf16(v1[0], v1[1]); w.w = cvt_pk_bf16(v1[2], v1[3]);
                    *(u32x4*)(rowp + bj * HALF) = w; } }
    }
};
struct EpiRes {
    static constexpr bool PERM = false;
    float* X; int ldc; float alpha;
    __device__ __forceinline__ void operator()(const f32x4 (&acc)[2][2][4][2], const Unit& u, int wr, int wc, int fr, int fq) const {
        const int row0 = u.pm * BM + wr * 64 + fr, col0 = u.pn * BM + wc * 32 + 4 * fq;
#pragma unroll
        for (int ai = 0; ai < 2; ++ai)
#pragma unroll
            for (int m = 0; m < 4; ++m) { float* rowp = X + (size_t)(row0 + ai * HALF + m * 16) * ldc + col0;
#pragma unroll
                for (int bj = 0; bj < 2; ++bj)
#pragma unroll
                    for (int n = 0; n < 2; ++n) { f32x4* p = (f32x4*)(rowp + bj * HALF + n * 16); const f32x4 xv = *p; *p = xv * alpha + acc[ai][bj][m][n]; }
                asm volatile("" ::: "memory"); }
    }
};

__device__ __forceinline__ f32x2 gelu_pk(f32x2 v) {
    const f32x2 av = __builtin_elementwise_abs(v), d = av * 0.2316418882f + 1.0f;
    f32x2 t; t.x = __builtin_amdgcn_rcpf(d.x); t.y = __builtin_amdgcn_rcpf(d.y);
    f32x2 q = t * 0.5307027145f + (-0.7265760135f); q = q * t + 0.7107068705f; q = q * t + (-0.142248368f); q = q * t + 0.127414796f; q = q * t;
    const f32x2 s = (v * v) * (-0.72134752044f);
    f32x2 e; e.x = __builtin_amdgcn_exp2f(s.x); e.y = __builtin_amdgcn_exp2f(s.y);
    const f32x2 m = v * (q * e), r = v - m;
    f32x2 o; o.x = v.x < 0.f ? m.x : r.x; o.y = v.y < 0.f ? m.y : r.y; return o;
}
__device__ __forceinline__ f32x4 gelu4(f32x4 v) { const f32x2 a = gelu_pk((f32x2){v.x, v.y}), b = gelu_pk((f32x2){v.z, v.w}); return (f32x4){a.x, a.y, b.x, b.y}; }
__device__ __forceinline__ float dpp_ror1(float x) { return __builtin_bit_cast(float, __builtin_amdgcn_update_dpp(0, __builtin_bit_cast(int, x), 0x121, 0xf, 0xf, false)); }
__device__ __forceinline__ float dpp_rol1(float x) { return __builtin_bit_cast(float, __builtin_amdgcn_update_dpp(0, __builtin_bit_cast(int, x), 0x12F, 0xf, 0xf, false)); }
__device__ __forceinline__ f32x4 ror4(f32x4 v) { return (f32x4){dpp_ror1(v.x), dpp_ror1(v.y), dpp_ror1(v.z), dpp_ror1(v.w)}; }
__device__ __forceinline__ f32x4 rol4(f32x4 v) { return (f32x4){dpp_rol1(v.x), dpp_rol1(v.y), dpp_rol1(v.z), dpp_rol1(v.w)}; }
__device__ __forceinline__ f32x4 sel4(bool c, f32x4 a, f32x4 b) { return (f32x4){c ? a.x : b.x, c ? a.y : b.y, c ? a.z : b.z, c ? a.w : b.w}; }

struct EpiGU {
    static constexpr bool PERM = true;
    bf16_t* H; int ldh; const float* cw; const float* cb; int dff; float* EG; float* EP; float* EU; LAS float* halo;
    __device__ __forceinline__ void operator()(const f32x4 (&acc)[2][2][4][2], const Unit& u, int wr, int wc, int fr, int fq) const {
        const int fl = wc * 32 + 8 * fq, f0 = u.pn * HALF + fl;
#pragma unroll
        for (int ai = 0; ai < 2; ++ai) { LAS float* hp = halo + ((ai * 2 + wr) * 2) * 128 + fl;
            if (fr == 0) { *(LAS f32x4*)(hp) = acc[ai][0][0][0]; *(LAS f32x4*)(hp + 4) = acc[ai][0][0][1]; }
            if (fr == 15) { *(LAS f32x4*)(hp + 128) = acc[ai][0][3][0]; *(LAS f32x4*)(hp + 132) = acc[ai][0][3][1]; } }
        asm volatile("s_waitcnt lgkmcnt(0)" ::: "memory"); __builtin_amdgcn_s_barrier(); asm volatile("" ::: "memory");
        const f32x4 zero4 = (f32x4){0.f, 0.f, 0.f, 0.f};
#pragma unroll
        for (int n = 0; n < 2; ++n) {
            const f32x4 w0 = *(const f32x4*)(cw + f0 + 4 * n), w1 = *(const f32x4*)(cw + dff + f0 + 4 * n), w2 = *(const f32x4*)(cw + 2 * dff + f0 + 4 * n), bb = *(const f32x4*)(cb + f0 + 4 * n);
#pragma unroll
            for (int ai = 0; ai < 2; ++ai) {
                const int idx = ai * 2 + wr;
                const f32x4 hprev = (idx > 0) ? *(const LAS f32x4*)(halo + ((idx - 1) * 2 + 1) * 128 + fl + 4 * n) : zero4;
                const f32x4 hnext = (idx < 3) ? *(const LAS f32x4*)(halo + ((idx + 1) * 2) * 128 + fl + 4 * n) : zero4;
                f32x4 rr[4], rl[4];
#pragma unroll
                for (int m = 0; m < 4; ++m) { rr[m] = ror4(acc[ai][0][m][n]); rl[m] = rol4(acc[ai][0][m][n]); }
#pragma unroll
                for (int m = 0; m < 4; ++m) {
                    const f32x4 pv = sel4(fr == 0, m > 0 ? rr[m > 0 ? m - 1 : 0] : hprev, rr[m]);
                    const f32x4 nx = sel4(fr == 15, m < 3 ? rl[m < 3 ? m + 1 : 3] : hnext, rl[m]);
                    const f32x4 y = w0 * pv + w1 * acc[ai][0][m][n] + w2 * nx + bb;
                    if (ai == 0 && m == 0) { if (wr == 0 && fr == 0) { const size_t eo = ((size_t)u.pm * 2 + 0) * dff + f0 + 4 * n; *(f32x4*)(EG + eo) = acc[0][0][0][n]; *(f32x4*)(EP + eo) = y; *(f32x4*)(EU + eo) = acc[0][1][0][n]; } }
                    if (ai == 1 && m == 3) { if (wr == 1 && fr == 15) { const size_t eo = ((size_t)u.pm * 2 + 1) * dff + f0 + 4 * n; *(f32x4*)(EG + eo) = acc[1][0][3][n]; *(f32x4*)(EP + eo) = y; *(f32x4*)(EU + eo) = acc[1][1][3][n]; } }
                    const f32x4 o = gelu4(y) * acc[ai][1][m][n];
                    u32x2 w; w.x = cvt_pk_bf16(o.x, o.y); w.y = cvt_pk_bf16(o.z, o.w);
                    *(u32x2*)(H + (size_t)(u.pm * BM + ai * HALF + wr * 64 + m * 16 + fr) * ldh + f0 + 4 * n) = w;
                }
            }
        }
    }
};

template <class Epi, bool ALIGN_EPI>
__device__ __forceinline__ void gemm_phase(LAS unsigned char* lds, const Gemm g, const StaticOrder& S, const Epi& E) {
    const int tid = launder(threadIdx.x), wid = __builtin_amdgcn_readfirstlane(tid >> 6), lane = tid & 63, wr = wid >> 2, wc = wid & 3, fr = lane & 15, fq = lane >> 4;
    const int K = g.K, nt = K / BK, lda = g.lda;
    unsigned voffA[2], voffB[2];
#pragma unroll
    for (int i = 0; i < 2; ++i) { int R, C; stage_rc(tid * 16 + i * 8192, R, C); const int Rb = Epi::PERM ? ((R & ~31) + perm32(R & 31)) : R;
        voffA[i] = (unsigned)(R * lda + C) * 2u; voffB[i] = (unsigned)(Rb * K + C) * 2u; }
    const size_t kstep = (size_t)(BK * 2);
    const size_t hstepA = (size_t)HALF * lda * 2, hstepB = (size_t)HALF * K * 2;
    const size_t tstepA = 2 * hstepA, tstepB = 2 * hstepB;
    const unsigned ldsw = (unsigned)wid * 1024u;
    const int aoff = lds_byte(wr * 64 + fr, fq * 8), boff = lds_byte(wc * 32 + fr, fq * 8);
#define PG8_SA(b, h) (((b) * 2 + (h)) * HTB)
#define PG8_SB(b, h) ((4 + (b) * 2 + (h)) * HTB)
#define PG8_STAGE(bufoff, gbase, voff) do { _Pragma("unroll") for (int _i = 0; _i < 2; ++_i) \
        __builtin_amdgcn_global_load_lds((const unsigned*)((const char*)(gbase) + (voff)[_i]), (LAS unsigned*)(lds + (bufoff) + ldsw + _i * 8192), 16, 0, 0); } while (0)
#define PG8_LDA(dst, b, h) do { _Pragma("unroll") for (int m = 0; m < 4; ++m) _Pragma("unroll") for (int k = 0; k < 2; ++k) dst[m][k] = *(const LAS bf16x8*)(lds + PG8_SA(b, h) + aoff + m * 2048 + k * 1024); } while (0)
#define PG8_LDB(dst, b, h) do { _Pragma("unroll") for (int n = 0; n < 2; ++n) _Pragma("unroll") for (int k = 0; k < 2; ++k) dst[n][k] = *(const LAS bf16x8*)(lds + PG8_SB(b, h) + boff + n * 2048 + k * 1024); } while (0)
#define PG8_MMA(ai, bj, At, Bt) do { __builtin_amdgcn_s_setprio(1); _Pragma("unroll") for (int m = 0; m < 4; ++m) _Pragma("unroll") for (int n = 0; n < 2; ++n) _Pragma("unroll") for (int k = 0; k < 2; ++k) \
        acc[ai][bj][m][n] = __builtin_amdgcn_mfma_f32_16x16x32_bf16(Bt[n][k], At[m][k], acc[ai][bj][m][n], 0, 0, 0); __builtin_amdgcn_s_setprio(0); } while (0)
#define PG8_WAIT_V(n) asm volatile("s_waitcnt vmcnt(" #n ")" ::: "memory")
#define PG8_WAIT_L(n) asm volatile("s_waitcnt lgkmcnt(" #n ")" ::: "memory")
#define PG8_BAR __builtin_amdgcn_s_barrier()
#define PG8_SCHED __builtin_amdgcn_sched_barrier(0)
    Unit cur, nxt; int ui = 0;
    if (!S.next(0, cur)) return;
    f32x4 acc[2][2][4][2];
#pragma unroll
    for (int a = 0; a < 2; ++a)
#pragma unroll
        for (int b = 0; b < 2; ++b)
#pragma unroll
            for (int m = 0; m < 4; ++m)
#pragma unroll
                for (int n = 0; n < 2; ++n) acc[a][b][m][n] = (f32x4){0.f, 0.f, 0.f, 0.f};
    bf16x8 At[4][2], B0[2][2], B1[2][2];
    const char* cA = (const char*)g.A + (size_t)cur.pm * tstepA; const char* cB = (const char*)g.Bt + (size_t)cur.pn * tstepB;
    PG8_STAGE(PG8_SB(0, 0), cB, voffB); PG8_STAGE(PG8_SB(0, 1), cB + hstepB, voffB); PG8_STAGE(PG8_SA(0, 0), cA, voffA); PG8_STAGE(PG8_SA(0, 1), cA + hstepA, voffA);
    if (wr == 1) PG8_BAR;
    PG8_WAIT_V(2); PG8_BAR;
    PG8_STAGE(PG8_SB(1, 0), cB + kstep, voffB); PG8_STAGE(PG8_SA(1, 0), cA + kstep, voffA); PG8_STAGE(PG8_SB(1, 1), cB + hstepB + kstep, voffB);
    PG8_WAIT_V(6); PG8_BAR;
    for (;;) {
        const bool has_next = S.next(ui + 1, nxt);
        const char* nA = has_next ? (const char*)g.A + (size_t)nxt.pm * tstepA : cA; const char* nB = has_next ? (const char*)g.Bt + (size_t)nxt.pn * tstepB : cB;
        for (int t = 0; t < nt; t += 2) {
            const bool last = (t == nt - 2);
            const char* a1 = cA + (size_t)(t + 1) * kstep;
            const char* a2 = last ? nA : cA + (size_t)(t + 2) * kstep; const char* b2 = last ? nB : cB + (size_t)(t + 2) * kstep;
            const char* a3 = a2 + kstep; const char* b3 = b2 + kstep;
            PG8_LDB(B0, 0, 0); PG8_LDB(B1, 0, 1); PG8_SCHED; PG8_LDA(At, 0, 0); PG8_STAGE(PG8_SA(1, 1), a1 + hstepA, voffA);
            PG8_WAIT_V(8); PG8_WAIT_L(0); PG8_BAR; PG8_MMA(0, 0, At, B0); PG8_MMA(0, 1, At, B1); PG8_BAR; PG8_SCHED;
            PG8_LDA(At, 0, 1); PG8_STAGE(PG8_SB(0, 0), b2, voffB); PG8_STAGE(PG8_SB(0, 1), b2 + hstepB, voffB); PG8_STAGE(PG8_SA(0, 0), a2, voffA);
            PG8_WAIT_V(8); PG8_WAIT_L(0); PG8_BAR; PG8_MMA(1, 0, At, B0); PG8_MMA(1, 1, At, B1); PG8_BAR; PG8_SCHED;
            PG8_LDB(B0, 1, 0); PG8_LDB(B1, 1, 1); PG8_SCHED; PG8_LDA(At, 1, 0); PG8_STAGE(PG8_SA(0, 1), a2 + hstepA, voffA);
            PG8_WAIT_V(8); PG8_WAIT_L(0); PG8_BAR; PG8_MMA(0, 0, At, B0); PG8_MMA(0, 1, At, B1); PG8_BAR; PG8_SCHED;
            PG8_LDA(At, 1, 1); PG8_STAGE(PG8_SB(1, 0), b3, voffB); PG8_STAGE(PG8_SB(1, 1), b3 + hstepB, voffB); PG8_STAGE(PG8_SA(1, 0), a3, voffA);
            PG8_WAIT_V(8); PG8_WAIT_L(0); PG8_BAR; PG8_MMA(1, 0, At, B0); PG8_MMA(1, 1, At, B1); PG8_BAR; PG8_SCHED;
        }
        if constexpr (ALIGN_EPI) { if (wr == 0) PG8_BAR; }
        E(acc, cur, wr, wc, fr, fq);
        if (!has_next) break;
#pragma unroll
        for (int a = 0; a < 2; ++a)
#pragma unroll
            for (int b = 0; b < 2; ++b)
#pragma unroll
                for (int m = 0; m < 4; ++m)
#pragma unroll
                    for (int n = 0; n < 2; ++n) acc[a][b][m][n] = (f32x4){0.f, 0.f, 0.f, 0.f};
        cur = nxt; cA = nA; cB = nB; ++ui;
        if constexpr (ALIGN_EPI) { if (wr == 1) PG8_BAR; }
    }
    PG8_WAIT_V(0);
    if constexpr (!ALIGN_EPI) { if (wr == 0) PG8_BAR; }
    PG8_BAR;
#undef PG8_SA
#undef PG8_SB
#undef PG8_STAGE
#undef PG8_LDA
#undef PG8_LDB
#undef PG8_MMA
#undef PG8_WAIT_V
#undef PG8_WAIT_L
#undef PG8_BAR
#undef PG8_SCHED
}
}

#define XB_TMO      128
#define XB_XCNT(j)  (256  + 64 * (j))
#define XB_XSUB(j)  (1280 + 64 * (j))
#define XB_XGEN(j)  (2304 + 64 * (j))
#define XB_TOP      3328
#define XB_TOPGEN   3392
#define XCD_BAR_WORDS 3456
#define XB_SPIN_CAP (1u << 18)

__device__ __forceinline__ unsigned xb_ld(unsigned* p)              { return __hip_atomic_load(p, __ATOMIC_RELAXED, __HIP_MEMORY_SCOPE_AGENT); }
__device__ __forceinline__ unsigned xb_add(unsigned* p, unsigned v) { return __hip_atomic_fetch_add(p, v, __ATOMIC_RELAXED, __HIP_MEMORY_SCOPE_AGENT); }
__device__ __forceinline__ unsigned xb_xcc_id() { return (unsigned)__builtin_amdgcn_s_getreg((3 << 11) | 20) & 0xFu; }
#define XB_SPIN(cond, bar) do { unsigned _sp = 0; while (cond) { __builtin_amdgcn_s_sleep(1); \
    if ((++_sp & 255u) == 0u) { if (xb_ld(&(bar)[XB_TMO])) break; if (_sp > XB_SPIN_CAP) { atomicAdd(&(bar)[XB_TMO], 1u); break; } } } } while (0)

struct XcdBarrier {
    unsigned* bar; unsigned x;
    volatile LAS unsigned* st;
};

__device__ __forceinline__ XcdBarrier xcd_barrier_post(unsigned* bar, volatile LAS unsigned* st) {
    XcdBarrier b; b.bar = bar; b.x = xb_xcc_id(); b.st = st;
    if (threadIdx.x == 0) (void)xb_add(&bar[XB_XCNT(b.x)], 1u);
    return b;
}
__device__ __forceinline__ void xcd_barrier_complete(unsigned* bar, unsigned x, unsigned& nloc, unsigned& nx) {
    const unsigned G = gridDim.x * gridDim.y * gridDim.z;
    unsigned sum, cnt, mine, sp = 0u;
    for (;;) {
        sum = 0u; cnt = 0u; mine = 0u;
#pragma unroll
        for (unsigned j = 0; j < 16; ++j) { const unsigned c = xb_ld(&bar[XB_XCNT(j)]); sum += c; cnt += (c > 0u) ? 1u : 0u; mine = (j == x) ? c : mine; }
        if (sum == G) break;
        __builtin_amdgcn_s_sleep(1);
        if ((++sp & 255u) == 0u) { if (xb_ld(&bar[XB_TMO])) break; if (sp > XB_SPIN_CAP) { atomicAdd(&bar[XB_TMO], 1u); break; } }
    }
    nloc = mine > 0u ? mine : 1u; nx = cnt > 0u ? cnt : 1u;
}

__device__ __forceinline__ void xcd_barrier(const XcdBarrier& b) {
    asm volatile("s_waitcnt vmcnt(0)" ::: "memory");
    __syncthreads();
    if (threadIdx.x == 0) {
        unsigned* bar = b.bar;
        __builtin_amdgcn_s_waitcnt(0);
        unsigned nloc = b.st[0], nx = b.st[1];
        if (nloc == 0u) { xcd_barrier_complete(bar, b.x, nloc, nx); b.st[0] = nloc; b.st[1] = nx; }
        const unsigned old = xb_add(&bar[XB_XSUB(b.x)], 1u);
        const unsigned gen = old / nloc;
        if (old + 1u == (gen + 1u) * nloc) {
            __builtin_amdgcn_fence(__ATOMIC_RELEASE, "agent");
            asm volatile("s_waitcnt vmcnt(0)" ::: "memory");
            const unsigned og = xb_add(&bar[XB_TOP], 1u);
            const unsigned tg = og / nx;
            if (og + 1u == (tg + 1u) * nx) xb_add(&bar[XB_TOPGEN], 1u);
            else XB_SPIN(xb_ld(&bar[XB_TOPGEN]) == tg, bar);
            __builtin_amdgcn_fence(__ATOMIC_ACQUIRE, "agent");
            xb_add(&bar[XB_XGEN(b.x)], 1u);
            asm volatile("s_waitcnt vmcnt(0)" ::: "memory");
        } else {
            XB_SPIN(xb_ld(&bar[XB_XGEN(b.x)]) == gen, bar);
            __builtin_amdgcn_fence(__ATOMIC_ACQUIRE, "agent");
            asm volatile("s_waitcnt vmcnt(0)" ::: "memory");
        }
    }
    __syncthreads();
}

struct Args { const float* in[19]; float* out; unsigned char* ws; };

#define LDS_WAIT() asm volatile("s_waitcnt lgkmcnt(0)" ::: "memory")

__device__ __forceinline__ void p0_transpose_item(const float* W, int K, int pitch, int nblk, bf16_t* WT, int row_off, LAS float* scr, int item, int lane, int il = 0) {
    const int kb = item / nblk, nb = item % nblk, k0 = 64 * kb, n0 = 32 * nb;
    const int rbase = il ? ((n0 >> 7) * 256 + (n0 & 127) + (il == 2 ? 128 : 0)) : row_off + n0;
#pragma unroll 8
    for (int i = 0; i < 32; ++i) { const int kk = 2 * i + (lane >> 5); scr[kk * 33 + (lane & 31)] = W[(size_t)(k0 + kk) * pitch + n0 + (lane & 31)]; }
    LDS_WAIT(); asm volatile("" ::: "memory");
    const int c = lane & 7;
#pragma unroll
    for (int j = 0; j < 4; ++j) { const int n = (lane >> 3) + 8 * j; const LAS float* s = scr + (8 * c) * 33 + n;
        u32x4 o; o.x = cvt_pk_bf16(s[0 * 33], s[1 * 33]); o.y = cvt_pk_bf16(s[2 * 33], s[3 * 33]); o.z = cvt_pk_bf16(s[4 * 33], s[5 * 33]); o.w = cvt_pk_bf16(s[6 * 33], s[7 * 33]);
        *(u32x4*)(WT + (size_t)(rbase + n) * K + k0 + 8 * c) = o; }
    LDS_WAIT(); asm volatile("" ::: "memory");
}

template <int MODE>
__device__ __forceinline__ void ln_row(const float* xrow, const bf16_t* xbrow, const bf16_t* yrow, const float* g, const float* b, float* of, bf16_t* ob, int lane) {
    f32x4 v[8]; float s = 0.f;
    if (MODE == 1) {
        const u32x2* xr = (const u32x2*)xbrow + lane; const u32x2* yr = (const u32x2*)yrow + lane; u32x2 xv[8], yv[8];
#pragma unroll
        for (int j = 0; j < 8; ++j) { xv[j] = xr[64 * j]; yv[j] = yr[64 * j]; }
#pragma unroll
        for (int j = 0; j < 8; ++j) { v[j] = (f32x4){bf_lo(xv[j].x), bf_hi(xv[j].x), bf_lo(xv[j].y), bf_hi(xv[j].y)} * ALPHA + (f32x4){bf_lo(yv[j].x), bf_hi(yv[j].x), bf_lo(yv[j].y), bf_hi(yv[j].y)}; s += (v[j].x + v[j].y) + (v[j].z + v[j].w); }
    } else {
        const f32x4* xr = (const f32x4*)xrow + lane;
#pragma unroll
        for (int j = 0; j < 8; ++j) { v[j] = xr[64 * j]; s += (v[j].x + v[j].y) + (v[j].z + v[j].w); }
    }
    const float mean = wave_sum(s) * (1.f / D); float s2 = 0.f;
#pragma unroll
    for (int j = 0; j < 8; ++j) { v[j] = v[j] - mean; s2 += (v[j].x * v[j].x + v[j].y * v[j].y) + (v[j].z * v[j].z + v[j].w * v[j].w); }
    const float rstd = 1.f / sqrtf(wave_sum(s2) * (1.f / D) + LN_EPS);
    const f32x4* gp = (const f32x4*)g + lane; const f32x4* bp = (const f32x4*)b + lane;
#pragma unroll
    for (int j = 0; j < 8; ++j) { const f32x4 o = v[j] * rstd * gp[64 * j] + bp[64 * j];
        if (of) ((f32x4*)of + lane)[64 * j] = o;
        if (ob) { u32x2 w; w.x = cvt_pk_bf16(o.x, o.y); w.y = cvt_pk_bf16(o.z, o.w); ((u32x2*)ob + lane)[64 * j] = w; } }
}

__global__ void __launch_bounds__(512, 2) fwd_kernel(Args args) {
    extern __shared__ __attribute__((aligned(16))) unsigned char lds_raw[];
    LAS unsigned char* lds = (LAS unsigned char*)lds_raw;
    cg::grid_group grid = cg::this_grid();
    const int tid0 = threadIdx.x, wave = __builtin_amdgcn_readfirstlane(tid0 >> 6);
    const int G = gridDim.x, bid = blockIdx.x;
    const int gw = bid * 8 + wave, NGW = G * 8;
    unsigned char* ws = args.ws;
    float* X = args.out;
    bf16_t* XB = (bf16_t*)(ws + WS_XB);
    bf16_t* Z = (bf16_t*)(ws + WS_Z);
    bf16_t* MIX = (bf16_t*)(ws + WS_MIX);
    bf16_t* YP = (bf16_t*)(ws + WS_YP);
    bf16_t* HB = (bf16_t*)(ws + WS_BIG);
    bf16_t* Y2 = (bf16_t*)(ws + WS_BIG + 352 * MiB);
    float* EDG = (float*)(ws + WS_EDGE);
    unsigned* BARW = (unsigned*)(ws + WS_BAR);
    volatile LAS unsigned* bar_st = (volatile LAS unsigned*)(lds + LDS_BYTES - 64);
    if (tid0 < 2) bar_st[tid0] = 0u;
    if (bid == 0) for (int i = tid0; i < XCD_BAR_WORDS; i += 512) __hip_atomic_store(BARW + i, 0u, __ATOMIC_RELAXED, __HIP_MEMORY_SCOPE_AGENT);
    bf16_t* PWT = (bf16_t*)(ws + WS_PW);
    bf16_t* Y1 = (bf16_t*)(ws + WS_Z);

    if (PH(0)) {
        const int tid = launder(tid0), lane = tid & 63;
        for (int it = bid; it < 256; it += G) {
            const int l = it >> 7, h = (it >> 5) & 3, cs = (it >> 4) & 1, kc = it & 15;
            LAS float* CW = (LAS float*)lds;
            {
                const int c = tid >> 2, d0 = (tid & 3) * 32;
                float a[32];
#pragma unroll
                for (int j = 0; j < 32; ++j) a[j] = 0.f;
                const float* Wf = args.in[7] + ((size_t)(l * 4 + h) * 128) * 128 + d0;
                for (int cp = 0; cp < 128; ++cp) {
                    const float fr_ = (float)((c * cp) & 127) * (1.f / 128.f);
                    const float tw = cs ? -__builtin_amdgcn_sinf(fr_) : __builtin_amdgcn_cosf(fr_);
                    const f32x4* wr_ = (const f32x4*)(Wf + (size_t)cp * 128);
#pragma unroll
                    for (int j = 0; j < 8; ++j) { const f32x4 w = wr_[j]; a[4 * j] += tw * w.x; a[4 * j + 1] += tw * w.y; a[4 * j + 2] += tw * w.z; a[4 * j + 3] += tw * w.w; }
                }
#pragma unroll
                for (int j = 0; j < 32; ++j) CW[c * 128 + d0 + j] = a[j] * 0.08838834764831845f;
            }
            __syncthreads();
            {
                const int k = kc * 128 + (tid & 127), d0 = (tid >> 7) * 32;
                float a[32];
#pragma unroll
                for (int j = 0; j < 32; ++j) a[j] = 0.f;
                const float* wrow = args.in[3] + ((size_t)l * D + k) * 4096 + 3584 + h * 128;
                for (int c4 = 0; c4 < 32; ++c4) {
                    const f32x4 wv = *(const f32x4*)(wrow + 4 * c4);
#pragma unroll
                    for (int cc = 0; cc < 4; ++cc) { const float av = wv[cc]; const LAS f32x4* cwp = (const LAS f32x4*)(CW + (4 * c4 + cc) * 128 + d0);
#pragma unroll
                        for (int j = 0; j < 8; ++j) { const f32x4 w = cwp[j]; a[4 * j] += av * w.x; a[4 * j + 1] += av * w.y; a[4 * j + 2] += av * w.z; a[4 * j + 3] += av * w.w; } }
                }
                bf16_t* dst = (bf16_t*)(ws + WS_WIN) + ((size_t)l * NZ + ZC_FR + cs * 512 + h * 128 + d0) * D + k;
#pragma unroll
                for (int j = 0; j < 32; ++j) dst[(size_t)j * D] = f2bf(a[j]);
            }
            __syncthreads();
        }
        {
            LAS float* scr = (LAS float*)(lds + wave * 16384);
            constexpr int I_IN = 32 * 112, I_O = 32 * 64, I_G = 32 * 176, I_D = 88 * 64, I_L = I_IN + I_O + 2 * I_G + I_D;
            for (int it = gw; it < 2 * I_L; it += NGW) {
                const int l = it / I_L; int r = it - l * I_L;
                if (r < I_IN) { p0_transpose_item(args.in[3] + (size_t)l * D * 4096, D, 4096, 112, (bf16_t*)(ws + WS_WIN) + (size_t)l * NZ * D, 0, scr, r, lane); continue; } r -= I_IN;
                if (r < I_O) { p0_transpose_item(args.in[9] + (size_t)l * D * D, D, D, 64, (bf16_t*)(ws + WS_WO) + (size_t)l * D * D, 0, scr, r, lane); continue; } r -= I_O;
                if (r < I_G) { p0_transpose_item(args.in[12] + (size_t)l * D * DFF, D, DFF, 176, (bf16_t*)(ws + WS_WGU) + (size_t)l * NGU * D, 0, scr, r, lane, 1); continue; } r -= I_G;
                if (r < I_G) { p0_transpose_item(args.in[13] + (size_t)l * D * DFF, D, DFF, 176, (bf16_t*)(ws + WS_WGU) + (size_t)l * NGU * D, DFF, scr, r, lane, 2); continue; } r -= I_G;
                p0_transpose_item(args.in[16] + (size_t)l * DFF * D, DFF, D, 64, (bf16_t*)(ws + WS_WD) + (size_t)l * D * DFF, 0, scr, r, lane);
            }
        }
        for (int i = bid * 512 + tid; i < 2 * 4 * 128 * 128; i += G * 512) { const int c = i & 127, d = (i >> 7) & 127, lg = i >> 14; PWT[i] = f2bf(args.in[5][((size_t)lg * 128 + c) * 128 + d]); }
        for (int m = gw; m < M; m += NGW) ln_row<0>(args.in[0] + (size_t)m * D, nullptr, nullptr, args.in[1], args.in[2], nullptr, XB + (size_t)m * D, lane);
    }
    grid.sync();
    const XcdBarrier xbar = xcd_barrier_post(BARW, bar_st);

    for (int l = 0; l < DEPTH; ++l) {
        if (PH(1)) {
            pg8::Gemm g{XB, (const bf16_t*)(ws + WS_WIN) + (size_t)l * NZ * D, M, NZ, D, D}; pg8::StaticOrder S; S.init(M, NZ, G, bid);
            pg8::EpiBf16 E{Z, NZ};
            pg8::gemm_phase<pg8::EpiBf16, true>(lds, g, S, E);
        }
        xcd_barrier(xbar);
        if (PH(2)) {
            const int tid = launder(tid0), lane = tid & 63;
            const float* gmix = args.in[8] + (size_t)l * D;
            LAS unsigned char* M1p = lds;
            LAS unsigned char* tile = lds + 128 * 272;
            for (int i = tid; i < 128 * 128; i += 512) {
                const int o = i >> 7, ks_ = (i >> 5) & 3, kq = (i >> 3) & 3, e = (i >> 2) & 1, q = i & 3;
                const int ro = o >> 6, k1 = o & 63, ri = ks_ >> 1, t1 = (ks_ & 1) * 32 + 16 * e + 4 * kq + q;
                const float fr_ = (float)((k1 * t1) & 63) * (1.f / 64.f);
                const float c = __builtin_amdgcn_cosf(fr_) * 0.125f, s = __builtin_amdgcn_sinf(fr_) * 0.125f;
                const float v = (ro == ri) ? c : (ro == 0 ? s : -s);
                *(LAS bf16_t*)(M1p + o * 272 + (i & 127) * 2) = f2bf(v);
            }
            __syncthreads();
            const int fr = lane & 15, fq = lane >> 4, qq = fr >> 2, pp = fr & 3;
            for (int it = bid; it < 1024; it += G) {
                const int b = it >> 7, t2 = (it >> 1) & 63, half = it & 1;
#pragma unroll
                for (int i = 0; i < 8; ++i) { const int idx = tid + 512 * i, row = idx >> 6, ch = idx & 63, ri = ch >> 5, cc = ch & 31;
                    const u32x4 v = *(const u32x4*)(Z + (size_t)(b * SEQ + 64 * row + t2) * NZ + ZC_FR + ri * 512 + half * 256 + cc * 8);
                    *(LAS u32x4*)(tile + row * 1056 + ri * 512 + cc * 16) = v; }
                __syncthreads();
                f32x4 acc[8][2];
#pragma unroll
                for (int a = 0; a < 8; ++a) { acc[a][0] = (f32x4){0.f, 0.f, 0.f, 0.f}; acc[a][1] = (f32x4){0.f, 0.f, 0.f, 0.f}; }
#pragma unroll
                for (int ks_ = 0; ks_ < 4; ++ks_) {
                    const int ri = ks_ >> 1, T0 = (ks_ & 1) * 32;
                    bf16x8 bfrag[2];
#pragma unroll
                    for (int nb = 0; nb < 2; ++nb) {
                        const int cb = (ri * 256 + 32 * wave + nb * 16 + 4 * pp) * 2;
                        const s16x4 lo = __builtin_amdgcn_ds_read_tr16_b64_v4i16((LAS s16x4*)(tile + (T0 + 4 * fq + qq) * 1056 + cb));
                        const s16x4 hi = __builtin_amdgcn_ds_read_tr16_b64_v4i16((LAS s16x4*)(tile + (T0 + 16 + 4 * fq + qq) * 1056 + cb));
                        bfrag[nb] = (bf16x8){lo.x, lo.y, lo.z, lo.w, hi.x, hi.y, hi.z, hi.w};
                    }
#pragma unroll
                    for (int ob = 0; ob < 8; ++ob) {
                        const bf16x8 af = *(const LAS bf16x8*)(M1p + (ob * 16 + fr) * 272 + (ks_ * 32 + fq * 8) * 2);
                        acc[ob][0] = __builtin_amdgcn_mfma_f32_16x16x32_bf16(af, bfrag[0], acc[ob][0], 0, 0, 0);
                        acc[ob][1] = __builtin_amdgcn_mfma_f32_16x16x32_bf16(af, bfrag[1], acc[ob][1], 0, 0, 0);
                    }
                }
#pragma unroll
                for (int ob = 0; ob < 4; ++ob)
#pragma unroll
                    for (int e = 0; e < 4; ++e) {
                        const int k1 = ob * 16 + 4 * fq + e;
                        const float fr_ = (float)(k1 * t2) * (1.f / 4096.f);
                        const float ct = __builtin_amdgcn_cosf(fr_), st = __builtin_amdgcn_sinf(fr_);
                        bf16_t* dst = YP + ((size_t)((b * 64 + k1) * 64 + t2)) * 1024 + half * 256 + 32 * wave + fr;
#pragma unroll
                        for (int nb = 0; nb < 2; ++nb) {
                            const float yr = acc[ob][nb][e], yi = acc[ob + 4][nb][e];
                            dst[nb * 16] = f2bf(yr * ct + yi * st);
                            dst[512 + nb * 16] = f2bf(yi * ct - yr * st);
                        }
                    }
                __syncthreads();
            }
            {
                LAS unsigned char* Ht = lds;
                LAS unsigned char* Pt = lds + 48 * 1040;
                LAS float* red = (LAS float*)(lds + 48 * 1040 + 32 * 1040);
                const bf16_t* pw = PWT + (size_t)l * 4 * 128 * 128;
                const float* pscale = args.in[6] + (size_t)l * 512;
                const int g_ = wave >> 1, dh = wave & 1;
                for (int it = bid; it < M / 32; it += G) {
                    const int r0 = it * 32, t0 = r0 & (SEQ - 1);
#pragma unroll
                    for (int i = 0; i < 6; ++i) { const int idx = tid + 512 * i, row = idx >> 6, ch = idx & 63; const int t = t0 - 8 + row;
                        u32x4 v = (u32x4){0u, 0u, 0u, 0u};
                        if (t >= 0 && t < SEQ) v = *(const u32x4*)(Z + (size_t)(r0 - 8 + row) * NZ + ZC_POOL + ch * 8);
                        *(LAS u32x4*)(Ht + row * 1040 + ch * 16) = v; }
                    __syncthreads();
                    {
                        const int c = tid, gi = c >> 7, hf = 1 << gi;
                        float s = 0.f;
                        for (int j = -hf; j < hf; ++j) s += bf2f(*(const LAS bf16_t*)(Ht + (8 + j) * 1040 + c * 2));
                        for (int tt = 0; tt < 32; ++tt) {
                            const int t = t0 + tt;
                            const int hi_ = (t + hf < SEQ) ? t + hf : SEQ, lo_ = (t - hf > 0) ? t - hf : 0;
                            const float cnt = (float)(hi_ - lo_);
                            const float hc = bf2f(*(const LAS bf16_t*)(Ht + (8 + tt) * 1040 + c * 2));
                            *(LAS bf16_t*)(Pt + tt * 1040 + c * 2) = f2bf(s / cnt - hc);
                            s += bf2f(*(const LAS bf16_t*)(Ht + (8 + tt + hf) * 1040 + c * 2)) - bf2f(*(const LAS bf16_t*)(Ht + (8 + tt - hf) * 1040 + c * 2));
                        }
                    }
                    __syncthreads();
                    f32x4 acc[2][4];
#pragma unroll
                    for (int a = 0; a < 2; ++a)
#pragma unroll
                        for (int n = 0; n < 4; ++n) acc[a][n] = (f32x4){0.f, 0.f, 0.f, 0.f};
#pragma unroll
                    for (int ks_ = 0; ks_ < 4; ++ks_) {
                        bf16x8 tf[2];
#pragma unroll
                        for (int mb = 0; mb < 2; ++mb) tf[mb] = *(const LAS bf16x8*)(Pt + (mb * 16 + fr) * 1040 + (g_ * 128 + ks_ * 32 + fq * 8) * 2);
#pragma unroll
                        for (int nb = 0; nb < 4; ++nb) {
                            const bf16x8 wf = *(const bf16x8*)(pw + ((size_t)(g_ * 128 + dh * 64 + nb * 16 + fr)) * 128 + ks_ * 32 + fq * 8);
                            acc[0][nb] = __builtin_amdgcn_mfma_f32_16x16x32_bf16(wf, tf[0], acc[0][nb], 0, 0, 0);
                            acc[1][nb] = __builtin_amdgcn_mfma_f32_16x16x32_bf16(wf, tf[1], acc[1][nb], 0, 0, 0);
                        }
                    }
                    float ssq[2] = {0.f, 0.f};
#pragma unroll
                    for (int nb = 0; nb < 4; ++nb) { const f32x4 sc = *(const f32x4*)(pscale + g_ * 128 + dh * 64 + nb * 16 + 4 * fq);
#pragma unroll
                        for (int mb = 0; mb < 2; ++mb) { acc[mb][nb] = acc[mb][nb] * sc; const f32x4 v = acc[mb][nb]; ssq[mb] += (v.x * v.x + v.y * v.y) + (v.z * v.z + v.w * v.w); } }
#pragma unroll
                    for (int mb = 0; mb < 2; ++mb) { ssq[mb] += __shfl_xor(ssq[mb], 16); ssq[mb] += __shfl_xor(ssq[mb], 32); if (fq == 0) red[(mb * 16 + fr) * 8 + wave] = ssq[mb]; }
                    __syncthreads();
#pragma unroll
                    for (int mb = 0; mb < 2; ++mb) {
                        const LAS f32x4* rp = (const LAS f32x4*)(red + (mb * 16 + fr) * 8); const f32x4 ra = rp[0], rb = rp[1];
                        const float tot = ((ra.x + ra.y) + (ra.z + ra.w)) + ((rb.x + rb.y) + (rb.z + rb.w));
                        const float rstd = 1.f / sqrtf(tot * (1.f / 512.f) + RMS_EPS);
                        bf16_t* orow = MIX + (size_t)(r0 + mb * 16 + fr) * D + 1024 + g_ * 128 + dh * 64 + 4 * fq;
#pragma unroll
                        for (int nb = 0; nb < 4; ++nb) { const f32x4 gm = *(const f32x4*)(gmix + 1024 + g_ * 128 + dh * 64 + nb * 16 + 4 * fq); const f32x4 o = acc[mb][nb] * rstd * gm;
                            u32x2 w; w.x = cvt_pk_bf16(o.x, o.y); w.y = cvt_pk_bf16(o.z, o.w); *(u32x2*)(orow + nb * 16) = w; }
                    }
                    __syncthreads();
                }
            }
            {
                const float* ca = args.in[4] + (size_t)l * 3 * 1024;
                float a0[16], a1[16], a2[16], gm[16];
#pragma unroll
                for (int h = 0; h < 2; ++h)
#pragma unroll
                    for (int j = 0; j < 8; ++j) { const int c = h * 512 + lane * 8 + j; a0[h * 8 + j] = ca[c]; a1[h * 8 + j] = ca[1024 + c]; a2[h * 8 + j] = ca[2048 + c]; gm[h * 8 + j] = gmix[c]; }
                for (int run = gw; run < M / 16; run += NGW) {
                    const int r0 = run * 16, t0 = r0 & (SEQ - 1);
                    float up[16], uc[16], un[16];
#define LOAD_U(dst, r) do { _Pragma("unroll") for (int h = 0; h < 2; ++h) { const bf16_t* zp = Z + (size_t)(r) * NZ + h * 512 + lane * 8; \
                        float c_[8], v_[8]; unpack8(*(const u32x4*)(zp + ZC_GC), c_); unpack8(*(const u32x4*)(zp + ZC_V), v_); \
                        _Pragma("unroll") for (int j = 0; j < 8; ++j) dst[h * 8 + j] = c_[j] * v_[j]; } } while (0)
                    if (t0 > 0) { LOAD_U(up, r0 - 1); } else {
#pragma unroll
                        for (int j = 0; j < 16; ++j) up[j] = 0.f; }
                    LOAD_U(uc, r0);
                    for (int i = 0; i < 16; ++i) {
                        const int r = r0 + i;
                        if (t0 + i < SEQ - 1) { LOAD_U(un, r + 1); } else {
#pragma unroll
                            for (int j = 0; j < 16; ++j) un[j] = 0.f; }
                        float y[16]; float ss = 0.f;
#pragma unroll
                        for (int h = 0; h < 2; ++h) { float gb[8]; unpack8(*(const u32x4*)(Z + (size_t)r * NZ + ZC_GB + h * 512 + lane * 8), gb);
#pragma unroll
                            for (int j = 0; j < 8; ++j) { const int k = h * 8 + j; y[k] = gb[j] * (a0[k] * up[k] + a1[k] * uc[k] + a2[k] * un[k]); ss += y[k] * y[k]; } }
                        const float rstd = 1.f / sqrtf(wave_sum(ss) * (1.f / 1024.f) + RMS_EPS);
#pragma unroll
                        for (int h = 0; h < 2; ++h) { u32x4 w;
                            w.x = cvt_pk_bf16(y[h * 8 + 0] * rstd * gm[h * 8 + 0], y[h * 8 + 1] * rstd * gm[h * 8 + 1]); w.y = cvt_pk_bf16(y[h * 8 + 2] * rstd * gm[h * 8 + 2], y[h * 8 + 3] * rstd * gm[h * 8 + 3]);
                            w.z = cvt_pk_bf16(y[h * 8 + 4] * rstd * gm[h * 8 + 4], y[h * 8 + 5] * rstd * gm[h * 8 + 5]); w.w = cvt_pk_bf16(y[h * 8 + 6] * rstd * gm[h * 8 + 6], y[h * 8 + 7] * rstd * gm[h * 8 + 7]);
                            *(u32x4*)(MIX + (size_t)r * D + h * 512 + lane * 8) = w; }
#pragma unroll
                        for (int j = 0; j < 16; ++j) { up[j] = uc[j]; uc[j] = un[j]; }
                    }
#undef LOAD_U
                }
            }
        }
        xcd_barrier(xbar);
        if (PH(3)) {
            const int tid = launder(tid0), lane = tid & 63;
            const float* gmix = args.in[8] + (size_t)l * D;
            LAS unsigned char* M2p = lds;
            LAS unsigned char* tile = lds + 64 * 272;
            LAS float* red = (LAS float*)(lds + 64 * 272 + 64 * 2080);
            for (int i = tid; i < 64 * 128; i += 512) {
                const int o = i >> 7, ks_ = (i >> 5) & 3, kq = (i >> 3) & 3, e = (i >> 2) & 1, q = i & 3;
                const int ri = ks_ >> 1, t2 = (ks_ & 1) * 32 + 16 * e + 4 * kq + q;
                const float fr_ = (float)((o * t2) & 63) * (1.f / 64.f);
                const float v = (ri == 0 ? __builtin_amdgcn_cosf(fr_) : __builtin_amdgcn_sinf(fr_)) * 0.125f;
                *(LAS bf16_t*)(M2p + o * 272 + (i & 127) * 2) = f2bf(v);
            }
            __syncthreads();
            const int fr = lane & 15, fq = lane >> 4, qq = fr >> 2, pp = fr & 3;
            for (int it = bid; it < 512; it += G) {
                const int b = it >> 6, k1 = it & 63;
                const bf16_t* src = YP + (size_t)((b * 64 + k1) * 64) * 1024;
#pragma unroll
                for (int i = 0; i < 16; ++i) { const int idx = tid + 512 * i, row = idx >> 7, ch = idx & 127;
                    *(LAS u32x4*)(tile + row * 2080 + ch * 16) = *(const u32x4*)(src + (size_t)row * 1024 + ch * 8); }
                __syncthreads();
                f32x4 acc[4][4];
#pragma unroll
                for (int a = 0; a < 4; ++a)
#pragma unroll
                    for (int n = 0; n < 4; ++n) acc[a][n] = (f32x4){0.f, 0.f, 0.f, 0.f};
#pragma unroll
                for (int ks_ = 0; ks_ < 4; ++ks_) {
                    const int ri = ks_ >> 1, T0 = (ks_ & 1) * 32;
                    bf16x8 af[4];
#pragma unroll
                    for (int ob = 0; ob < 4; ++ob) af[ob] = *(const LAS bf16x8*)(M2p + (ob * 16 + fr) * 272 + (ks_ * 32 + fq * 8) * 2);
#pragma unroll
                    for (int nb = 0; nb < 4; ++nb) {
                        const int cb = (ri * 512 + 64 * wave + nb * 16 + 4 * pp) * 2;
                        const s16x4 lo = __builtin_amdgcn_ds_read_tr16_b64_v4i16((LAS s16x4*)(tile + (T0 + 4 * fq + qq) * 2080 + cb));
                        const s16x4 hi = __builtin_amdgcn_ds_read_tr16_b64_v4i16((LAS s16x4*)(tile + (T0 + 16 + 4 * fq + qq) * 2080 + cb));
                        const bf16x8 bf = (bf16x8){lo.x, lo.y, lo.z, lo.w, hi.x, hi.y, hi.z, hi.w};
#pragma unroll
                        for (int ob = 0; ob < 4; ++ob) acc[ob][nb] = __builtin_amdgcn_mfma_f32_16x16x32_bf16(af[ob], bf, acc[ob][nb], 0, 0, 0);
                    }
                }
#pragma unroll
                for (int ob = 0; ob < 4; ++ob)
#pragma unroll
                    for (int e = 0; e < 4; ++e) {
                        float s = 0.f;
#pragma unroll
                        for (int nb = 0; nb < 4; ++nb) s += acc[ob][nb][e] * acc[ob][nb][e];
                        s += __shfl_xor(s, 1); s += __shfl_xor(s, 2); s += __shfl_xor(s, 4); s += __shfl_xor(s, 8);
                        if (fr == 0) red[(ob * 16 + 4 * fq + e) * 8 + wave] = s;
                    }
                __syncthreads();
                float gmv[4];
#pragma unroll
                for (int nb = 0; nb < 4; ++nb) gmv[nb] = gmix[1536 + 64 * wave + nb * 16 + fr];
#pragma unroll
                for (int ob = 0; ob < 4; ++ob)
#pragma unroll
                    for (int e = 0; e < 4; ++e) {
                        const int k2 = ob * 16 + 4 * fq + e;
                        const LAS f32x4* rp = (const LAS f32x4*)(red + k2 * 8); const f32x4 ra = rp[0], rb = rp[1];
                        const float tot = ((ra.x + ra.y) + (ra.z + ra.w)) + ((rb.x + rb.y) + (rb.z + rb.w));
                        const float rstd = 1.f / sqrtf(tot * (1.f / 512.f) + RMS_EPS);
                        bf16_t* orow = MIX + (size_t)(b * SEQ + k1 + 64 * k2) * D + 1536 + 64 * wave + fr;
#pragma unroll
                        for (int nb = 0; nb < 4; ++nb) orow[nb * 16] = f2bf(acc[ob][nb][e] * rstd * gmv[nb]);
                    }
                __syncthreads();
            }
        }
        xcd_barrier(xbar);
        if (PH(4)) {
            pg8::Gemm g{MIX, (const bf16_t*)(ws + WS_WO) + (size_t)l * D * D, M, D, D, D}; pg8::StaticOrder S; S.init(M, D, G, bid);
            pg8::EpiBf16 E{Y1, D};
            pg8::gemm_phase<pg8::EpiBf16, true>(lds, g, S, E);
        }
        xcd_barrier(xbar);
        if (PH(5)) { const int lane = launder(tid0) & 63; for (int m = gw; m < M; m += NGW) ln_row<1>(nullptr, XB + (size_t)m * D, Y1 + (size_t)m * D, args.in[10] + (size_t)l * D, args.in[11] + (size_t)l * D, nullptr, XB + (size_t)m * D, lane); }
        xcd_barrier(xbar);
        if (PH(6)) {
            pg8::Gemm g{XB, (const bf16_t*)(ws + WS_WGU) + (size_t)l * NGU * D, M, NGU, D, D}; pg8::StaticOrder S; S.init(M, NGU, G, bid);
            pg8::EpiGU E{HB, DFF, args.in[14] + (size_t)l * 3 * DFF, args.in[15] + (size_t)l * DFF, DFF, EDG, EDG + EDGE_ELEMS, EDG + 2 * EDGE_ELEMS, (LAS float*)(lds + pg8::STAGE_BYTES)};
            pg8::gemm_phase<pg8::EpiGU, true>(lds, g, S, E);
        }
        xcd_barrier(xbar);
        if (PH(7)) {
            const int tid = launder(tid0);
            const float* cw = args.in[14] + (size_t)l * 3 * DFF;
            constexpr int NCH = DFF / 4;
            for (int idx = bid * 512 + tid; idx < 128 * 2 * NCH; idx += G * 512) {
                const int ch = idx % NCH, pe = idx / NCH, e = pe & 1, pm = pe >> 1, f = ch * 4;
                if (e == 0 ? ((pm & 15) == 0) : ((pm & 15) == 15)) continue;
                const size_t eo = (size_t)pe * DFF + f, no = (size_t)(e == 0 ? (pm - 1) * 2 + 1 : (pm + 1) * 2) * DFF + f;
                const f32x4 wv = *(const f32x4*)(cw + (e == 0 ? 0 : 2 * DFF) + f);
                const f32x4 y = *(const f32x4*)(EDG + EDGE_ELEMS + eo) + wv * *(const f32x4*)(EDG + no);
                const f32x4 o = pg8::gelu4(y) * *(const f32x4*)(EDG + 2 * EDGE_ELEMS + eo);
                u32x2 w; w.x = cvt_pk_bf16(o.x, o.y); w.y = cvt_pk_bf16(o.z, o.w);
                *(u32x2*)(HB + (size_t)(pm * 256 + (e == 0 ? 0 : 255)) * DFF + f) = w;
            }
        }
        xcd_barrier(xbar);
        if (PH(8)) {
            pg8::Gemm g{HB, (const bf16_t*)(ws + WS_WD) + (size_t)l * D * DFF, M, D, DFF, DFF}; pg8::StaticOrder S; S.init(M, D, G, bid);
            pg8::EpiBf16 E{Y2, D};
            pg8::gemm_phase<pg8::EpiBf16, true>(lds, g, S, E);
        }
        xcd_barrier(xbar);
        if (PH(9)) { const int lane = launder(tid0) & 63; float* const fo = (l == DEPTH - 1) ? X : nullptr; bf16_t* const bo = (l == DEPTH - 1) ? nullptr : XB;
            for (int m = gw; m < M; m += NGW) ln_row<1>(nullptr, XB + (size_t)m * D, Y2 + (size_t)m * D, args.in[17] + (size_t)l * D, args.in[18] + (size_t)l * D, fo ? fo + (size_t)m * D : nullptr, bo ? bo + (size_t)m * D : nullptr, lane); }
        xcd_barrier(xbar);
    }
}

extern "C" void kernel_launch(void* const* d_in, const int* in_sizes, int n_in, void* d_out, int out_size, void* d_ws, size_t ws_size, hipStream_t stream) {
    static int grid_blocks = 0;
    if (grid_blocks == 0) {
        if (n_in != 19 || out_size != M * D || ws_size < WS_END) { fprintf(stderr, "kernel_launch: unexpected shapes (n_in %d, out %d, ws %zu, need %zu)\n", n_in, out_size, ws_size, (size_t)WS_END); grid_blocks = -1; return; }
        int dev = 0, cus = 0, per_cu = 0;
        (void)hipGetDevice(&dev);
        (void)hipDeviceGetAttribute(&cus, hipDeviceAttributeMultiprocessorCount, dev);
        if (hipFuncSetAttribute((const void*)fwd_kernel, hipFuncAttributeMaxDynamicSharedMemorySize, LDS_BYTES) != hipSuccess) { fprintf(stderr, "kernel_launch: hipFuncSetAttribute failed\n"); grid_blocks = -1; return; }
        if (hipOccupancyMaxActiveBlocksPerMultiprocessor(&per_cu, (const void*)fwd_kernel, 512, LDS_BYTES) != hipSuccess || per_cu < 1) { fprintf(stderr, "kernel_launch: occupancy query failed (%d)\n", per_cu); (void)hipGetLastError(); per_cu = 1; }
        grid_blocks = cus * per_cu;
        if (grid_blocks > 256) grid_blocks = 256;
    }
    if (grid_blocks < 0) return;
    Args a{};
    for (int i = 0; i < 19; ++i) a.in[i] = (const float*)d_in[i];
    a.out = (float*)d_out; a.ws = (unsigned char*)d_ws;
    void* kargs[] = {&a};
    hipError_t e = hipLaunchCooperativeKernel((const void*)fwd_kernel, dim3(grid_blocks), dim3(512), kargs, LDS_BYTES, stream);
    if (e != hipSuccess) fprintf(stderr, "cooperative launch failed: %s (grid %d)\n", hipGetErrorString(e), grid_blocks);
}
```
